# Optimizing an MI355X kernel written in HIP

```python
import math
import jax, jax.numpy as jnp
from jax import lax
import numpy as np

D_MODEL = 1024
BATCH = 4
SEQ = 8192
DEPTH = 4

CHUNK = 64
EPS = 1e-6
NEG_INF = -1e30
N_BRANCH = 3
BR_WIDTH = 512

SGU_BLOCK = 128
SGU_GROUPS = 8
SGU_GROUP_DIM = BR_WIDTH // SGU_GROUPS

MLA_HEADS = 8
MLA_NOPE = 64
MLA_ROPE = 32
MLA_V = 64
MLA_QK = MLA_NOPE + MLA_ROPE
MLA_Q_RANK = 256
MLA_KV_RANK = 128
ROPE_BASE = 10000.0
Q_BLOCK = 128

CA_HEADS = 8
CA_HEAD_DIM = BR_WIDTH // CA_HEADS
LEFT_CHUNKS = 8
BAND = (LEFT_CHUNKS + 1) * CHUNK
REL_CLIP = 128

IN_WIDTHS = (BR_WIDTH, BR_WIDTH, BR_WIDTH,
             MLA_Q_RANK, MLA_KV_RANK, MLA_ROPE, BR_WIDTH,
             BR_WIDTH, BR_WIDTH, BR_WIDTH, BR_WIDTH,
             N_BRANCH * D_MODEL)
D_IN = sum(IN_WIDTHS)

kernel_name = "hybrid_sgu_mla_chunkattn_streaming"


def rmsnorm(x, g):
    xf = x.astype(jnp.float32)
    y = xf * lax.rsqrt(jnp.mean(xf * xf, axis=-1, keepdims=True) + EPS)
    return (y * g.astype(jnp.float32)).astype(x.dtype)


def layernorm(x, g, b):
    xf = x.astype(jnp.float32)
    mu = jnp.mean(xf, axis=-1, keepdims=True)
    xc = xf - mu
    y = xc * lax.rsqrt(jnp.mean(xc * xc, axis=-1, keepdims=True) + EPS)
    return (y * g.astype(jnp.float32) + b.astype(jnp.float32)).astype(x.dtype)


def apply_rope(x, pos):
    half = x.shape[-1] // 2
    inv = ROPE_BASE ** (-jnp.arange(half, dtype=jnp.float32) / half)
    ang = pos.astype(jnp.float32)[:, None] * inv[None, :]
    cos = jnp.cos(ang)[:, None, :]
    sin = jnp.sin(ang)[:, None, :]
    xf = x.astype(jnp.float32)
    x1, x2 = xf[..., :half], xf[..., half:]
    return jnp.concatenate([x1 * cos - x2 * sin, x1 * sin + x2 * cos], axis=-1).astype(x.dtype)


def sgu_mixer(u, v, ln_g, ln_b, w_s, b_s):
    B, S, _ = u.shape
    nb = S // SGU_BLOCK
    v = layernorm(v, ln_g, ln_b)
    vb = v.reshape(B, nb, SGU_BLOCK, SGU_GROUPS, SGU_GROUP_DIM)
    tri = jnp.tril(jnp.ones((SGU_BLOCK, SGU_BLOCK), dtype=bool))
    ws = jnp.where(tri[None], w_s, 0.0).astype(v.dtype)
    mixed = jnp.einsum('gts,bnsgc->bntgc', ws, vb) + b_s.T.astype(v.dtype)[None, None, :, :, None]
    return u * mixed.reshape(B, S, BR_WIDTH)


def mla_mixer(q_down, kv_down, k_rope_in, q_norm_g, kv_norm_g, w_uq, w_ukv, pos):
    B, S, _ = q_down.shape
    cq = rmsnorm(q_down, q_norm_g)
    q = (cq @ w_uq).reshape(B, S, MLA_HEADS, MLA_QK)
    q = jnp.concatenate([q[..., :MLA_NOPE], apply_rope(q[..., MLA_NOPE:], pos)], axis=-1)
    ckv = rmsnorm(kv_down, kv_norm_g)
    kv = (ckv @ w_ukv).reshape(B, S, MLA_HEADS, MLA_NOPE + MLA_V)
    k_nope, v = kv[..., :MLA_NOPE], kv[..., MLA_NOPE:]
    k_r = apply_rope(k_rope_in[:, :, None, :], pos)
    k = jnp.concatenate([k_nope, jnp.broadcast_to(k_r, (B, S, MLA_HEADS, MLA_ROPE))], axis=-1)
    scale = MLA_QK ** -0.5
    nqb = S // Q_BLOCK
    qb = q.reshape(B, nqb, Q_BLOCK, MLA_HEADS, MLA_QK).transpose(1, 0, 2, 3, 4)
    key_chunk = jnp.arange(S) // CHUNK

    def block(args):
        qi, bi = args
        s = jnp.einsum('bqhd,bkhd->bhqk', qi, k).astype(jnp.float32) * scale
        q_chunk = (bi * Q_BLOCK + jnp.arange(Q_BLOCK)) // CHUNK
        mask = key_chunk[None, :] <= q_chunk[:, None]
        s = jnp.where(mask[None, None], s, NEG_INF)
        p = jax.nn.softmax(s, axis=-1).astype(v.dtype)
        return jnp.einsum('bhqk,bkhd->bqhd', p, v)

    o = lax.map(block, (qb, jnp.arange(nqb)))
    return o.transpose(1, 0, 2, 3, 4).reshape(B, S, MLA_HEADS * MLA_V)


def chunk_band_mixer(q, k, v, rel_table):
    B, S, _ = q.shape
    nc = S // CHUNK
    pad = LEFT_CHUNKS * CHUNK
    q = q.reshape(B, S, CA_HEADS, CA_HEAD_DIM)
    k = k.reshape(B, S, CA_HEADS, CA_HEAD_DIM)
    v = v.reshape(B, S, CA_HEADS, CA_HEAD_DIM)
    kp = jnp.pad(k, ((0, 0), (pad, 0), (0, 0), (0, 0)))
    vp = jnp.pad(v, ((0, 0), (pad, 0), (0, 0), (0, 0)))
    qc = q.reshape(B, nc, CHUNK, CA_HEADS, CA_HEAD_DIM).transpose(1, 0, 2, 3, 4)
    i = jnp.arange(CHUNK)
    j = jnp.arange(BAND)
    dist = i[:, None] + pad - j[None, :]
    idx = jnp.clip(dist, -REL_CLIP, REL_CLIP) + REL_CLIP
    bias = rel_table[:, idx].astype(jnp.float32)
    scale = CA_HEAD_DIM ** -0.5

    def chunk(args):
        qi, ci = args
        kb = lax.dynamic_slice_in_dim(kp, ci * CHUNK, BAND, axis=1)
        vb = lax.dynamic_slice_in_dim(vp, ci * CHUNK, BAND, axis=1)
        s = jnp.einsum('bqhd,bkhd->bhqk', qi, kb).astype(jnp.float32) * scale + bias[None]
        valid = j >= (LEFT_CHUNKS - ci) * CHUNK
        s = jnp.where(valid[None, None, None, :], s, NEG_INF)
        p = jax.nn.softmax(s, axis=-1).astype(vb.dtype)
        return jnp.einsum('bhqk,bkhd->bqhd', p, vb)

    o = lax.map(chunk, (qc, jnp.arange(nc)))
    return o.transpose(1, 0, 2, 3, 4).reshape(B, S, BR_WIDTH)


def setup_inputs(seed: int = 0) -> dict:
    key = jax.random.key(seed)
    ks = jax.random.split(key, 16)
    f32 = jnp.float32
    L, D = DEPTH, D_MODEL
    nrm = lambda k, shape, s: jax.random.normal(k, shape, f32) * s
    return {
        "x": jax.random.normal(ks[0], (BATCH, SEQ, D), f32),
        "w_in": nrm(ks[1], (L, D, D_IN), D ** -0.5),
        "pre_g": 1.0 + nrm(ks[2], (L, D), 0.1),
        "post_g": 1.0 + nrm(ks[3], (L, D), 0.1),
        "sgu_ln_g": 1.0 + nrm(ks[4], (L, BR_WIDTH), 0.1),
        "sgu_ln_b": nrm(ks[5], (L, BR_WIDTH), 0.02),
        "sgu_w": nrm(ks[6], (L, SGU_GROUPS, SGU_BLOCK, SGU_BLOCK), SGU_BLOCK ** -0.5),
        "sgu_b": 1.0 + nrm(ks[7], (L, SGU_GROUPS, SGU_BLOCK), 0.1),
        "mla_q_norm_g": 1.0 + nrm(ks[8], (L, MLA_Q_RANK), 0.1),
        "mla_kv_norm_g": 1.0 + nrm(ks[9], (L, MLA_KV_RANK), 0.1),
        "mla_w_uq": nrm(ks[10], (L, MLA_Q_RANK, MLA_HEADS * MLA_QK), MLA_Q_RANK ** -0.5),
        "mla_w_ukv": nrm(ks[11], (L, MLA_KV_RANK, MLA_HEADS * (MLA_NOPE + MLA_V)), MLA_KV_RANK ** -0.5),
        "ca_rel_bias": nrm(ks[12], (L, CA_HEADS, 2 * REL_CLIP + 1), 0.5),
        "w_branch": nrm(ks[13], (L, N_BRANCH, BR_WIDTH, D), BR_WIDTH ** -0.5),
        "gate_b": nrm(ks[14], (L, N_BRANCH, D), 0.1),
        "w_out": nrm(ks[15], (L, D, D), D ** -0.5),
    }


def reference(x, w_in, pre_g, post_g, sgu_ln_g, sgu_ln_b, sgu_w, sgu_b,
              mla_q_norm_g, mla_kv_norm_g, mla_w_uq, mla_w_ukv, ca_rel_bias,
              w_branch, gate_b, w_out):
    B, S, D = x.shape
    pos = jnp.arange(S)
    offsets = [0]
    for w in IN_WIDTHS:
        offsets.append(offsets[-1] + w)
    for l in range(DEPTH):
        xn = rmsnorm(x, pre_g[l])
        proj = xn @ w_in[l]
        (u_a, v_a, z_a, qd_b, kvd_b, kr_b, z_b,
         q_c, k_c, v_c, z_c, g_logits) = [proj[..., offsets[n]:offsets[n + 1]] for n in range(len(IN_WIDTHS))]
        y_a = sgu_mixer(u_a, v_a, sgu_ln_g[l], sgu_ln_b[l], sgu_w[l], sgu_b[l]) * jax.nn.silu(z_a)
        y_b = mla_mixer(qd_b, kvd_b, kr_b, mla_q_norm_g[l], mla_kv_norm_g[l],
                        mla_w_uq[l], mla_w_ukv[l], pos) * jax.nn.silu(z_b)
        y_c = chunk_band_mixer(q_c, k_c, v_c, ca_rel_bias[l]) * jax.nn.silu(z_c)
        ys = jnp.stack([y_a, y_b, y_c], axis=2)
        br = jnp.einsum('bsnc,ncd->bsnd', ys, w_branch[l])
        gates = jax.nn.sigmoid(g_logits.reshape(B, S, N_BRANCH, D) + gate_b[l])
        merged = jnp.sum(gates * br, axis=2)
        x = x + rmsnorm(merged @ w_out[l], post_g[l])
    return x
```

```cpp
#include <hip/hip_runtime.h>
#include <hip/hip_cooperative_groups.h>
#include <cstdio>
#include <cstdint>
namespace cg = cooperative_groups;
namespace pg8 {
#define PG8_LAS __attribute__((address_space(3)))
typedef unsigned short bf16_t;
typedef short bf16x8 __attribute__((ext_vector_type(8)));
typedef float f32x4 __attribute__((ext_vector_type(4)));
typedef unsigned u32x4 __attribute__((ext_vector_type(4)));
constexpr int BM = 256, BK = 64, HALF = 128, HTB = HALF * BK * 2  , STAGE_BYTES = 8 * HTB, NXCD = 8, WGM = 8;

__host__ __device__ __forceinline__ int lds_byte(int r, int c) { const int st = (r >> 4) * 2 + (c >> 5), rr = r & 15, cc = c & 31, ob = rr * 64 + cc * 2; return st * 1024 + (ob ^ (((ob >> 9) & 1) << 5)); }
__host__ __device__ __forceinline__ void stage_rc(int b, int& R, int& C) { const int st = b / 1024, sb = b % 1024, swz = sb ^ (((sb >> 9) & 1) << 5); R = (st >> 1) * 16 + swz / 64; C = (st & 1) * 32 + (swz % 64) / 2; }
__host__ __device__ __forceinline__ int perm32(int rho) { const int n = rho >> 4, i = rho & 15; return 8 * (i >> 2) + 4 * n + (i & 3); }

struct Unit { int pm, pn; };
struct Gemm { const bf16_t* A; const bf16_t* Bt; int M, N, K, lda, ldb; };

struct StaticOrder {
    int nM, nN, nwg, G, c;
    __host__ __device__ void init(int M, int N, int G_, int c_) { nM = M / BM; nN = N / BM; nwg = nM * nN; G = G_; c = c_; }
    __host__ __device__ bool next(int i, Unit& u) const {
        const long L = (long)i * G + c; if (L >= nwg) return false;
        int wgid = (int)L; { const int q = nwg / NXCD, r = nwg % NXCD, xcd = wgid % NXCD, off = wgid / NXCD; wgid = (xcd < r ? xcd * (q + 1) : r * (q + 1) + (xcd - r) * q) + off; }
        const int nig = WGM * nN, gid = wgid / nig, fm = gid * WGM, gsz = (nM - fm) < WGM ? (nM - fm) : WGM;
        u.pm = fm + ((wgid % nig) % gsz); u.pn = (wgid % nig) / gsz; return true;
    }
    __device__ __forceinline__ void a_ready(const Unit&) const {}
    __device__ __forceinline__ void done(const Unit&) const {}
};

__device__ __forceinline__ unsigned cvt_pk_bf16(float lo, float hi) { unsigned r; asm volatile("v_cvt_pk_bf16_f32 %0, %1, %2" : "=v"(r) : "v"(lo), "v"(hi)); return r; }
__device__ __forceinline__ int opaque_tid() { int t = threadIdx.x; asm volatile("" : "+v"(t)); return t; }
__device__ __forceinline__ float sigm(float v) { return __builtin_amdgcn_rcpf(1.0f + __builtin_amdgcn_exp2f(-1.4426950408889634f * v)); }
__device__ __forceinline__ float bflo(unsigned w) { return __uint_as_float(w << 16); }
__device__ __forceinline__ float bfhi(unsigned w) { return __uint_as_float(w & 0xffff0000u); }
__device__ __forceinline__ f32x4 shx32(f32x4 v) { f32x4 r; r[0] = __shfl_xor(v[0], 32); r[1] = __shfl_xor(v[1], 32); r[2] = __shfl_xor(v[2], 32); r[3] = __shfl_xor(v[3], 32); return r; }
constexpr float RMS_EPS = 1e-6f;

struct EpiIn {
    static constexpr bool PERM = true, AFTER_DRAIN = false;
    bf16_t* O; int ldc; const float* gate_b; float* rowstat;
    __device__ __forceinline__ void operator()(const f32x4 (&acc)[2][2][4][2], const Unit& u, int wr, int wc, int fr, int fq) const {
        const int row0 = u.pm * BM + wr * 64 + fr; const int col0 = u.pn * BM + wc * 32 + 8 * fq;
        const bool gate = (u.pn >= 16 && u.pn < 28);
        f32x4 bv[2][2];
#pragma unroll
        for (int bj = 0; bj < 2; ++bj)
#pragma unroll
            for (int n = 0; n < 2; ++n) bv[bj][n] = gate ? *(const f32x4*)(gate_b + (col0 - 4096) + bj * HALF + 4 * n) : (f32x4){0.f, 0.f, 0.f, 0.f};
#pragma unroll
        for (int ai = 0; ai < 2; ++ai)
#pragma unroll
            for (int m = 0; m < 4; ++m) { const int row = row0 + ai * HALF + m * 16; bf16_t* rowp = O + (size_t)row * ldc + col0; float ss = 0.f;
#pragma unroll
                for (int bj = 0; bj < 2; ++bj) { f32x4 v0 = acc[ai][bj][m][0] + bv[bj][0], v1 = acc[ai][bj][m][1] + bv[bj][1];
                    if (gate) { v0[0] = sigm(v0[0]); v0[1] = sigm(v0[1]); v0[2] = sigm(v0[2]); v0[3] = sigm(v0[3]); v1[0] = sigm(v1[0]); v1[1] = sigm(v1[1]); v1[2] = sigm(v1[2]); v1[3] = sigm(v1[3]); }
                    if (u.pn == 28 || (u.pn == 29 && bj == 0)) ss += (v0[0] * v0[0] + v0[1] * v0[1]) + (v0[2] * v0[2] + v0[3] * v0[3]) + (v1[0] * v1[0] + v1[1] * v1[1]) + (v1[2] * v1[2] + v1[3] * v1[3]);
                    u32x4 w; w.x = cvt_pk_bf16(v0[0], v0[1]); w.y = cvt_pk_bf16(v0[2], v0[3]); w.z = cvt_pk_bf16(v1[0], v1[1]); w.w = cvt_pk_bf16(v1[2], v1[3]);
                    *(u32x4*)(rowp + bj * HALF) = w; }
                if (u.pn >= 28) { ss += __shfl_xor(ss, 16); ss += __shfl_xor(ss, 32); if (fq == 0) rowstat[8 * row + (u.pn - 28) * 4 + wc] = ss; }
                asm volatile("" ::: "memory"); }
    }
};
struct EpiQ {
    static constexpr bool PERM = true, AFTER_DRAIN = false;
    bf16_t* O; const float* rowstat; const float* rcos; const float* rsin;
    __device__ __forceinline__ void operator()(const f32x4 (&acc)[2][2][4][2], const Unit& u, int wr, int wc, int fr, int fq) const {
        const int row0 = u.pm * BM + wr * 64 + fr; const int col0 = u.pn * BM + wc * 32 + 8 * fq;
        const float sgn = (fq >> 1) ? 1.f : -1.f; const int i0 = 8 * (fq & 1);
#pragma unroll
        for (int ai = 0; ai < 2; ++ai)
#pragma unroll
            for (int m = 0; m < 4; ++m) { const int row = row0 + ai * HALF + m * 16; const f32x4 rs4 = *(const f32x4*)(rowstat + 8 * row); const float sc = 1.0f / sqrtf(((rs4[0] + rs4[1]) + (rs4[2] + rs4[3])) * (1.0f / 256.0f) + RMS_EPS); const int pos = row & 8191;
#pragma unroll
                for (int bj = 0; bj < 2; ++bj) { f32x4 v0 = acc[ai][bj][m][0] * sc, v1 = acc[ai][bj][m][1] * sc;
                    const int grp = u.pn * 8 + bj * 4 + wc;
                    if (grp % 3 == 2) { const f32x4 p0 = shx32(v0), p1 = shx32(v1);
                        const f32x4 c0 = *(const f32x4*)(rcos + pos * 16 + i0), c1 = *(const f32x4*)(rcos + pos * 16 + i0 + 4), s0 = *(const f32x4*)(rsin + pos * 16 + i0), s1 = *(const f32x4*)(rsin + pos * 16 + i0 + 4);
                        v0 = v0 * c0 + (p0 * s0) * sgn; v1 = v1 * c1 + (p1 * s1) * sgn; }
                    u32x4 w; w.x = cvt_pk_bf16(v0[0], v0[1]); w.y = cvt_pk_bf16(v0[2], v0[3]); w.z = cvt_pk_bf16(v1[0], v1[1]); w.w = cvt_pk_bf16(v1[2], v1[3]);
                    *(u32x4*)(O + (size_t)row * 768 + col0 + bj * HALF) = w; }
                asm volatile("" ::: "memory"); }
    }
};
struct EpiKV {
    static constexpr bool PERM = true, AFTER_DRAIN = false;
    bf16_t* O; const float* rowstat;
    __device__ __forceinline__ void operator()(const f32x4 (&acc)[2][2][4][2], const Unit& u, int wr, int wc, int fr, int fq) const {
        const int row0 = u.pm * BM + wr * 64 + fr; const int col0 = u.pn * BM + wc * 32 + 8 * fq;
#pragma unroll
        for (int ai = 0; ai < 2; ++ai)
#pragma unroll
            for (int m = 0; m < 4; ++m) { const int row = row0 + ai * HALF + m * 16; const f32x4 rs4 = *(const f32x4*)(rowstat + 8 * row + 4); const float sc = 1.0f / sqrtf(((rs4[0] + rs4[1]) + (rs4[2] + rs4[3])) * (1.0f / 128.0f) + RMS_EPS);
#pragma unroll
                for (int bj = 0; bj < 2; ++bj) { const f32x4 v0 = acc[ai][bj][m][0] * sc, v1 = acc[ai][bj][m][1] * sc;
                    u32x4 w; w.x = cvt_pk_bf16(v0[0], v0[1]); w.y = cvt_pk_bf16(v0[2], v0[3]); w.z = cvt_pk_bf16(v1[0], v1[1]); w.w = cvt_pk_bf16(v1[2], v1[3]);
                    *(u32x4*)(O + (size_t)row * 1024 + col0 + bj * HALF) = w; }
                asm volatile("" ::: "memory"); }
    }
};
template <int I> struct EpiMerge {
    static constexpr bool PERM = true, AFTER_DRAIN = false;
    const bf16_t* G; int ldg; float* macc; bf16_t* O;
    __device__ __forceinline__ void operator()(const f32x4 (&acc)[2][2][4][2], const Unit& u, int wr, int wc, int fr, int fq) const {
        const int row0 = u.pm * BM + wr * 64 + fr; const int col0 = u.pn * BM + wc * 32 + 8 * fq;
#pragma unroll
        for (int ai = 0; ai < 2; ++ai)
#pragma unroll
            for (int m = 0; m < 4; ++m) { const int row = row0 + ai * HALF + m * 16;
#pragma unroll
                for (int bj = 0; bj < 2; ++bj) { const int col = col0 + bj * HALF; const u32x4 gw = *(const u32x4*)(G + (size_t)row * ldg + col);
                    f32x4 v0 = acc[ai][bj][m][0] * (f32x4){bflo(gw.x), bfhi(gw.x), bflo(gw.y), bfhi(gw.y)}, v1 = acc[ai][bj][m][1] * (f32x4){bflo(gw.z), bfhi(gw.z), bflo(gw.w), bfhi(gw.w)};
                    float* mp = macc + (size_t)row * 1024 + col;
                    if (I > 0) { v0 += *(const f32x4*)mp; v1 += *(const f32x4*)(mp + 4); }
                    if (I < 2) { *(f32x4*)mp = v0; *(f32x4*)(mp + 4) = v1; }
                    else { u32x4 w; w.x = cvt_pk_bf16(v0[0], v0[1]); w.y = cvt_pk_bf16(v0[2], v0[3]); w.z = cvt_pk_bf16(v1[0], v1[1]); w.w = cvt_pk_bf16(v1[2], v1[3]); *(u32x4*)(O + (size_t)row * 1024 + col) = w; } }
                asm volatile("" ::: "memory"); }
    }
};
struct EpiF32 {
    static constexpr bool PERM = false, AFTER_DRAIN = false;
    float* O; int ldc;
    __device__ __forceinline__ void operator()(const f32x4 (&acc)[2][2][4][2], const Unit& u, int wr, int wc, int fr, int fq) const {
        const int row0 = u.pm * BM + wr * 64 + fr; const int col0 = u.pn * BM + wc * 32 + 4 * fq;
#pragma unroll
        for (int ai = 0; ai < 2; ++ai)
#pragma unroll
            for (int m = 0; m < 4; ++m) { float* rowp = O + (size_t)(row0 + ai * HALF + m * 16) * ldc + col0;
#pragma unroll
                for (int bj = 0; bj < 2; ++bj)
#pragma unroll
                    for (int n = 0; n < 2; ++n) *(f32x4*)(rowp + bj * HALF + n * 16) = acc[ai][bj][m][n]; }
    }
};

template <class Epi, class Sched, bool ALIGN_EPI = false, bool SP2 = false>
__device__ __forceinline__ void gemm_phase(PG8_LAS unsigned char* lds, const Gemm g, const Sched& S, const Epi& E) {
    const int tid = opaque_tid(), wid = __builtin_amdgcn_readfirstlane(tid >> 6), lane = tid & 63, wr = wid >> 2, wc = wid & 3, fr = lane & 15, fq = lane >> 4;
    int Kop = g.K; asm volatile("" : "+s"(Kop)); const int K = Kop, nt = K / BK;
    unsigned voffA[2], voffB[2];
#pragma unroll
    for (int i = 0; i < 2; ++i) { int R, C; stage_rc(tid * 16 + i * 8192, R, C); const int Rb = Epi::PERM ? ((R & ~31) + perm32(R & 31)) : R;
        voffA[i] = (unsigned)(R * g.lda + C) * 2u; voffB[i] = (unsigned)(Rb * g.ldb + C) * 2u; }
    const size_t kstep = (size_t)(BK * 2);
    const size_t hstepA = (size_t)HALF * g.lda * 2, hstepB = (size_t)HALF * g.ldb * 2;
    const size_t tstepA = 2 * hstepA, tstepB = 2 * hstepB;
    const unsigned ldsw = (unsigned)wid * 1024u;
    const int aoff = lds_byte(wr * 64 + fr, fq * 8), boff = lds_byte(wc * 32 + fr, fq * 8);
#define PG8_SA(b, h) (((b) * 2 + (h)) * HTB)
#define PG8_SB(b, h) ((4 + (b) * 2 + (h)) * HTB)
#define PG8_STAGE(bufoff, gbase, voff) do { _Pragma("unroll") for (int _i = 0; _i < 2; ++_i) \
        __builtin_amdgcn_global_load_lds((const unsigned*)((const char*)(gbase) + (voff)[_i]), (PG8_LAS unsigned*)(lds + (bufoff) + ldsw + _i * 8192), 16, 0, 0); } while (0)
#define PG8_LDA(dst, b, h) do { _Pragma("unroll") for (int m = 0; m < 4; ++m) _Pragma("unroll") for (int k = 0; k < 2; ++k) dst[m][k] = *(const PG8_LAS bf16x8*)(lds + PG8_SA(b, h) + aoff + m * 2048 + k * 1024); } while (0)
#define PG8_LDB(dst, b, h) do { _Pragma("unroll") for (int n = 0; n < 2; ++n) _Pragma("unroll") for (int k = 0; k < 2; ++k) dst[n][k] = *(const PG8_LAS bf16x8*)(lds + PG8_SB(b, h) + boff + n * 2048 + k * 1024); } while (0)
#define PG8_MMA(ai, bj, At, Bt) do { __builtin_amdgcn_s_setprio(1); _Pragma("unroll") for (int m = 0; m < 4; ++m) _Pragma("unroll") for (int n = 0; n < 2; ++n) _Pragma("unroll") for (int k = 0; k < 2; ++k) \
        acc[ai][bj][m][n] = __builtin_amdgcn_mfma_f32_16x16x32_bf16(Bt[n][k], At[m][k], acc[ai][bj][m][n], 0, 0, 0); __builtin_amdgcn_s_setprio(0); } while (0)
#define PG8_WAIT_V(n) asm volatile("s_waitcnt vmcnt(" #n ")" ::: "memory")
#define PG8_WAIT_L(n) asm volatile("s_waitcnt lgkmcnt(" #n ")" ::: "memory")
#define PG8_BAR __builtin_amdgcn_s_barrier()
#define PG8_SCHED __builtin_amdgcn_sched_barrier(0)
    Unit cur, nxt; int ui = 0;
    if (!S.next(0, cur)) return;
    f32x4 acc[2][2][4][2];
#pragma unroll
    for (int a = 0; a < 2; ++a)
#pragma unroll
        for (int b = 0; b < 2; ++b)
#pragma unroll
            for (int m = 0; m < 4; ++m)
#pragma unroll
                for (int n = 0; n < 2; ++n) acc[a][b][m][n] = (f32x4){0.f, 0.f, 0.f, 0.f};
    bf16x8 At[4][2], B0[2][2], B1[2][2];
    const char* cA = (const char*)g.A + (size_t)cur.pm * tstepA; const char* cB = (const char*)g.Bt + (size_t)cur.pn * tstepB;
    S.a_ready(cur);
    if constexpr (SP2) {
        PG8_STAGE(PG8_SB(0, 0), cB, voffB); PG8_STAGE(PG8_SB(0, 1), cB + hstepB, voffB); PG8_STAGE(PG8_SA(0, 0), cA, voffA); PG8_STAGE(PG8_SA(0, 1), cA + hstepA, voffA);
        if (wr == 1) PG8_BAR;
        PG8_WAIT_V(2); PG8_BAR;
        PG8_STAGE(PG8_SB(1, 0), cB + kstep, voffB); PG8_STAGE(PG8_SA(1, 0), cA + kstep, voffA); PG8_STAGE(PG8_SB(1, 1), cB + hstepB + kstep, voffB);
        PG8_WAIT_V(6); PG8_BAR;
    } else {
        PG8_STAGE(PG8_SB(0, 0), cB, voffB); PG8_STAGE(PG8_SA(0, 0), cA, voffA); PG8_STAGE(PG8_SB(0, 1), cB + hstepB, voffB); PG8_STAGE(PG8_SA(0, 1), cA + hstepA, voffA);
        if (wr == 1) PG8_BAR;
        PG8_WAIT_V(4); PG8_BAR;
        PG8_STAGE(PG8_SB(1, 0), cB + kstep, voffB); PG8_STAGE(PG8_SA(1, 0), cA + kstep, voffA); PG8_STAGE(PG8_SB(1, 1), cB + hstepB + kstep, voffB);
        PG8_WAIT_V(6); PG8_BAR;
    }
    for (;;) {
        const bool has_next = S.next(ui + 1, nxt);
        const char* nA = has_next ? (const char*)g.A + (size_t)nxt.pm * tstepA : cA; const char* nB = has_next ? (const char*)g.Bt + (size_t)nxt.pn * tstepB : cB;
        for (int t = 0; t < nt; t += 2) {
            const bool last = (t == nt - 2);
            const char* a1 = cA + (size_t)(t + 1) * kstep;
            const char* a2 = last ? nA : cA + (size_t)(t + 2) * kstep; const char* b2 = last ? nB : cB + (size_t)(t + 2) * kstep;
            const char* a3 = a2 + kstep; const char* b3 = b2 + kstep;
            if (last && has_next) S.a_ready(nxt);
            if constexpr (SP2) {
            PG8_LDB(B0, 0, 0); PG8_LDB(B1, 0, 1); PG8_SCHED; PG8_LDA(At, 0, 0); PG8_STAGE(PG8_SA(1, 1), a1 + hstepA, voffA);
            PG8_WAIT_V(8); PG8_WAIT_L(0); PG8_BAR; PG8_MMA(0, 0, At, B0); PG8_MMA(0, 1, At, B1); PG8_BAR; PG8_SCHED;
            PG8_LDA(At, 0, 1); PG8_STAGE(PG8_SB(0, 0), b2, voffB); PG8_STAGE(PG8_SB(0, 1), b2 + hstepB, voffB); PG8_STAGE(PG8_SA(0, 0), a2, voffA);
            PG8_WAIT_V(8); PG8_WAIT_L(0); PG8_BAR; PG8_MMA(1, 0, At, B0); PG8_MMA(1, 1, At, B1); PG8_BAR; PG8_SCHED;
            PG8_LDB(B0, 1, 0); PG8_LDB(B1, 1, 1); PG8_SCHED; PG8_LDA(At, 1, 0); PG8_STAGE(PG8_SA(0, 1), a2 + hstepA, voffA);
            PG8_WAIT_V(8); PG8_WAIT_L(0); PG8_BAR; PG8_MMA(0, 0, At, B0); PG8_MMA(0, 1, At, B1); PG8_BAR; PG8_SCHED;
            PG8_LDA(At, 1, 1); PG8_STAGE(PG8_SB(1, 0), b3, voffB); PG8_STAGE(PG8_SB(1, 1), b3 + hstepB, voffB); PG8_STAGE(PG8_SA(1, 0), a3, voffA);
            PG8_WAIT_V(8); PG8_WAIT_L(0); PG8_BAR; PG8_MMA(1, 0, At, B0); PG8_MMA(1, 1, At, B1); PG8_BAR; PG8_SCHED;
            } else {
            PG8_LDB(B0, 0, 0); PG8_SCHED; PG8_LDA(At, 0, 0); PG8_STAGE(PG8_SA(1, 1), a1 + hstepA, voffA);
            PG8_WAIT_L(8); PG8_BAR; PG8_WAIT_L(0); PG8_MMA(0, 0, At, B0); PG8_BAR; PG8_SCHED;
            PG8_LDB(B1, 0, 1); PG8_STAGE(PG8_SB(0, 0), b2, voffB);
            PG8_BAR; PG8_WAIT_L(0); PG8_MMA(0, 1, At, B1); PG8_BAR;
            PG8_LDA(At, 0, 1); PG8_STAGE(PG8_SA(0, 0), a2, voffA);
            PG8_BAR; PG8_WAIT_L(0); PG8_MMA(1, 0, At, B0); PG8_BAR; PG8_SCHED;
            PG8_STAGE(PG8_SB(0, 1), b2 + hstepB, voffB);
            PG8_WAIT_V(6); PG8_BAR; PG8_MMA(1, 1, At, B1); PG8_BAR;
            PG8_LDB(B0, 1, 0); PG8_SCHED; PG8_LDA(At, 1, 0); PG8_STAGE(PG8_SA(0, 1), a2 + hstepA, voffA);
            PG8_WAIT_L(8); PG8_BAR; PG8_WAIT_L(0); PG8_MMA(0, 0, At, B0); PG8_BAR; PG8_SCHED;
            PG8_LDB(B1, 1, 1); PG8_STAGE(PG8_SB(1, 0), b3, voffB);
            PG8_BAR; PG8_WAIT_L(0); PG8_MMA(0, 1, At, B1); PG8_BAR;
            PG8_LDA(At, 1, 1); PG8_STAGE(PG8_SA(1, 0), a3, voffA);
            PG8_BAR; PG8_WAIT_L(0); PG8_MMA(1, 0, At, B0); PG8_BAR; PG8_SCHED;
            PG8_STAGE(PG8_SB(1, 1), b3 + hstepB, voffB);
            PG8_WAIT_V(6); PG8_BAR; PG8_MMA(1, 1, At, B1); PG8_BAR;
            }
        }
        if constexpr (ALIGN_EPI) { if (wr == 0) PG8_BAR; }
        if constexpr (!Epi::AFTER_DRAIN) { E(acc, cur, wr, wc, fr, fq); S.done(cur); }
        if (!has_next) break;
#pragma unroll
        for (int a = 0; a < 2; ++a)
#pragma unroll
            for (int b = 0; b < 2; ++b)
#pragma unroll
                for (int m = 0; m < 4; ++m)
#pragma unroll
                    for (int n = 0; n < 2; ++n) acc[a][b][m][n] = (f32x4){0.f, 0.f, 0.f, 0.f};
        cur = nxt; cA = nA; cB = nB; ++ui;
        if constexpr (ALIGN_EPI) { if (wr == 1) PG8_BAR; }
    }
    PG8_WAIT_V(0);
    if constexpr (!ALIGN_EPI) { if (wr == 0) PG8_BAR; }
    PG8_BAR;
    if constexpr (Epi::AFTER_DRAIN) { E.fused(acc, cur, wr, wc, fr, fq, lds, wid, lane); S.done(cur); }
#undef PG8_SA
#undef PG8_SB
#undef PG8_STAGE
#undef PG8_LDA
#undef PG8_LDB
#undef PG8_MMA
#undef PG8_WAIT_V
#undef PG8_WAIT_L
#undef PG8_BAR
#undef PG8_SCHED
}
}

typedef unsigned short bf16;
typedef short bf16x8 __attribute__((ext_vector_type(8)));
typedef short s16x4 __attribute__((ext_vector_type(4)));
typedef float f32x4 __attribute__((ext_vector_type(4)));
typedef float f32x16 __attribute__((ext_vector_type(16)));
typedef unsigned u32x4 __attribute__((ext_vector_type(4)));
typedef unsigned u32x2 __attribute__((ext_vector_type(2)));
#define LAS __attribute__((address_space(3)))
constexpr int NWAVES = 8, NTHR = 512;
constexpr int DM = 1024, SEQ = 8192, NB = 4, DEPTH = 4, MTOT = NB * SEQ, MH = MTOT / 2;
constexpr int DIN = 7584, PW = 7680;
constexpr int C_UA = 0, C_VA = 512, C_ZA = 1024, C_ZB = 1536, C_QC = 2048, C_KC = 2560, C_VC = 3072, C_ZC = 3584, C_GATE = 4096, C_QD = 7168, C_KVD = 7424, C_KR = 7552;
constexpr float EPS = 1e-6f, LOG2E = 1.4426950408889634f;
constexpr size_t MiB = 1u << 20;
constexpr size_t WS_ROPE = 1 * MiB, WS_STAT = 2 * MiB, WS_KR = 3 * MiB, WS_W = 4 * MiB, W_LAYER = 21 * MiB;
constexpr size_t WO_IN = 0, WO_BR = 15 * MiB, WO_OUT = 18 * MiB, WO_UQ = 20 * MiB, WO_UKV = 20 * MiB + 384 * 1024, WO_SGU = 20 * MiB + 640 * 1024;
constexpr size_t WS_XB = 88 * MiB, WS_PROJ = 120 * MiB, WS_MQ = 360 * MiB, WS_MKV = 384 * MiB, WS_MACC = 416 * MiB, WS_END = 480 * MiB;
constexpr int LDS_BYTES = 147456;

__device__ __forceinline__ float wave_sum(float v) {
#pragma unroll
    for (int o = 1; o < 64; o <<= 1) v += __shfl_xor(v, o);
    return v;
}
__device__ __forceinline__ unsigned pk2(float lo, float hi) { return pg8::cvt_pk_bf16(lo, hi); }
__device__ __forceinline__ float bf2f(bf16 b) { return __uint_as_float((unsigned)b << 16); }
__device__ __forceinline__ bf16 f2bf(float f) { return (bf16)(pk2(f, 0.f) & 0xffffu); }
__device__ __forceinline__ float siluf(float z) { return z * __builtin_amdgcn_rcpf(1.0f + __builtin_amdgcn_exp2f(-LOG2E * z)); }
#define LDS_WAIT() asm volatile("s_waitcnt lgkmcnt(0)" ::: "memory")

__device__ __forceinline__ void tr_item(const float* W, int ldw, int nseg, const float* kscale, bf16* WT, int K, LAS float* scr, int item, int lane) {
    const int nblk = nseg / 32, kb = item / nblk, nb = item % nblk, k0 = 64 * kb, n0 = 32 * nb;
#pragma unroll 8
    for (int i = 0; i < 32; ++i) { const int kk = 2 * i + (lane >> 5); float w = W[(size_t)(k0 + kk) * ldw + n0 + (lane & 31)]; if (kscale) w *= kscale[k0 + kk]; scr[kk * 33 + (lane & 31)] = w; }
    LDS_WAIT();
    const int c = lane & 7;
#pragma unroll
    for (int j = 0; j < 4; ++j) { const int n = (lane >> 3) + 8 * j; const LAS float* s = scr + (8 * c) * 33 + n;
        u32x4 o; o.x = pk2(s[0 * 33], s[1 * 33]); o.y = pk2(s[2 * 33], s[3 * 33]); o.z = pk2(s[4 * 33], s[5 * 33]); o.w = pk2(s[6 * 33], s[7 * 33]);
        *(u32x4*)(WT + (size_t)(n0 + n) * K + k0 + 8 * c) = o; }
    LDS_WAIT();
}

constexpr int AT_K = 0, AT_V = 24576, AT_WS = 40960, AT_TBL = 43008;
__device__ __forceinline__ s16x4 vtr(const LAS unsigned char* p) { typedef short v4i16_t __attribute__((ext_vector_type(4))); return __builtin_bit_cast(s16x4, __builtin_amdgcn_ds_read_tr16_b64_v4i16((LAS v4i16_t*)p)); }

template <int DQK, bool BIAS>
__device__ __forceinline__ void attn_unit(LAS unsigned char* lds, const bf16* Qp, int ldq, const bf16* Kp, int ldk, const bf16* KRp, int ldkr, const bf16* Vp, int ldv, bf16* Zp, int ldz, int q0, const float* tblsrc, float C2) {
    constexpr int ND = DQK / 16;
    const int tid = pg8::opaque_tid(), lane = tid & 63, r32 = lane & 31, hi = lane >> 5; const int wid = __builtin_amdgcn_readfirstlane(tid >> 6);
    const int c0 = q0 >> 6, cw = c0 + (wid >> 1);
    const int t_hi = c0 + 3;
    const int t_lo = BIAS ? (c0 > 8 ? c0 - 8 : 0) : 0;
    const int w_lo = BIAS ? (cw > 8 ? cw - 8 : 0) : 0;
    bf16x8 qr[ND];
    { const bf16* Qw = Qp + (size_t)(q0 + wid * 32 + r32) * ldq + hi * 8;
#pragma unroll
      for (int d0 = 0; d0 < ND; ++d0) qr[d0] = *(const bf16x8*)(Qw + d0 * 16); }
    LAS float* wsf = (LAS float*)(lds + AT_WS) + wid * 64;
    LAS float* tbl = (LAS float*)(lds + AT_TBL);
    if (BIAS) { for (int i = tid; i < 257; i += NTHR) tbl[i] = tblsrc[i] * LOG2E; }
    u32x4 kreg0, kreg1, vreg; kreg1 = (u32x4){0u, 0u, 0u, 0u};
    const bf16* ksrc = Kp + (size_t)lane * ldk + wid * 8;
    const bf16* krsrc = KRp + (size_t)lane * ldkr + (wid & 3) * 8;
    const bf16* vsrc = Vp + (size_t)(16 * (wid & 3) + (lane >> 2)) * ldv + (wid >> 2) * 32 + (lane & 3) * 8;
#define AT_GLOAD(kt) do { kreg0 = *(const u32x4*)(ksrc + (size_t)(kt) * 64 * ldk); if (DQK == 96 && wid < 4) kreg1 = *(const u32x4*)(krsrc + (size_t)(kt) * 64 * ldkr); vreg = *(const u32x4*)(vsrc + (size_t)(kt) * 64 * ldv); } while (0)
#define AT_LSTORE(b) do { *(LAS u32x4*)(lds + AT_K + (b) * 12288 + tid * 16) = kreg0; if (DQK == 96 && wid < 4) *(LAS u32x4*)(lds + AT_K + (b) * 12288 + 8192 + tid * 16) = kreg1; *(LAS u32x4*)(lds + AT_V + (b) * 8192 + tid * 16) = vreg; } while (0)
    float m_run = -1e30f, l_run = 0.f; f32x16 o[2]; o[0] = (f32x16){}; o[1] = (f32x16){};
    AT_GLOAD(t_lo); AT_LSTORE(0);
    __syncthreads();
    int buf = 0;
    for (int kt = t_lo; kt <= t_hi; ++kt, buf ^= 1) {
        const bool more = kt < t_hi;
        if (more) AT_GLOAD(kt + 1);
        if (kt >= w_lo && kt <= cw) {
            f32x16 p0 = (f32x16){}, p1 = (f32x16){};
            const LAS unsigned char* kb = lds + AT_K + buf * 12288 + hi * 1024 + r32 * 16;
#pragma unroll
            for (int d0 = 0; d0 < ND; ++d0) {
                const bf16x8 a0 = *(const LAS bf16x8*)(kb + d0 * 2048), a1 = *(const LAS bf16x8*)(kb + d0 * 2048 + 512);
                p0 = __builtin_amdgcn_mfma_f32_32x32x16_bf16(a0, qr[d0], p0, 0, 0, 0); p1 = __builtin_amdgcn_mfma_f32_32x32x16_bf16(a1, qr[d0], p1, 0, 0, 0); }
            if (BIAS) {
                if (cw - kt >= 3) { const float bc = tbl[256];
#pragma unroll
                    for (int r = 0; r < 16; ++r) { p0[r] = p0[r] * C2 + bc; p1[r] = p1[r] * C2 + bc; } }
                else { const int dq = (q0 + wid * 32 + r32) - (kt * 64 + 4 * hi);
#pragma unroll
                    for (int r = 0; r < 16; ++r) { const int d = dq - ((r & 3) + 8 * (r >> 2)); const int i0 = (d < 128 ? d : 128) + 128, i1 = (d - 32 < 128 ? d - 32 : 128) + 128;
                        p0[r] = p0[r] * C2 + tbl[i0]; p1[r] = p1[r] * C2 + tbl[i1]; } }
            } else {
#pragma unroll
                for (int r = 0; r < 16; ++r) { p0[r] *= C2; p1[r] *= C2; }
            }
            float rm = fmaxf(p0[0], p1[0]);
#pragma unroll
            for (int r = 1; r < 16; ++r) rm = fmaxf(rm, fmaxf(p0[r], p1[r]));
            rm = fmaxf(rm, __shfl_xor(rm, 32));
            const float mnew = fmaxf(m_run, rm);
            if (__any(mnew > m_run)) {
                const float f = __builtin_amdgcn_exp2f(m_run - mnew); l_run *= f; m_run = mnew;
                if (hi == 0) wsf[r32] = f;
                LDS_WAIT();
#pragma unroll
                for (int g = 0; g < 4; ++g) { const f32x4 fv = *(const LAS f32x4*)(wsf + 8 * g + 4 * hi);
#pragma unroll
                    for (int e = 0; e < 4; ++e) { o[0][4 * g + e] *= fv[e]; o[1][4 * g + e] *= fv[e]; } }
                LDS_WAIT();
            }
            float ls = 0.f;
#pragma unroll
            for (int r = 0; r < 16; ++r) { p0[r] = __builtin_amdgcn_exp2f(p0[r] - m_run); p1[r] = __builtin_amdgcn_exp2f(p1[r] - m_run); ls += p0[r] + p1[r]; }
            l_run += ls;
            u32x4 pw[4];
#pragma unroll
            for (int e = 0; e < 4; ++e) { pw[0][e] = pk2(p0[2 * e], p0[2 * e + 1]); pw[1][e] = pk2(p0[8 + 2 * e], p0[8 + 2 * e + 1]); pw[2][e] = pk2(p1[2 * e], p1[2 * e + 1]); pw[3][e] = pk2(p1[8 + 2 * e], p1[8 + 2 * e + 1]); }
            const LAS unsigned char* vp = lds + AT_V + buf * 8192 + ((lane >> 4) & 1) * 32 + (lane & 3) * 8 + (4 * hi + ((lane & 15) >> 2)) * 64;
#pragma unroll
            for (int d0 = 0; d0 < 2; ++d0)
#pragma unroll
                for (int s = 0; s < 4; ++s) { const s16x4 lo = vtr(vp + d0 * 4096 + s * 1024), hh = vtr(vp + d0 * 4096 + s * 1024 + 512);
                    const bf16x8 vf = (bf16x8){lo[0], lo[1], lo[2], lo[3], hh[0], hh[1], hh[2], hh[3]};
                    o[d0] = __builtin_amdgcn_mfma_f32_32x32x16_bf16(__builtin_bit_cast(bf16x8, pw[s]), vf, o[d0], 0, 0, 0); }
        }
        if (more) AT_LSTORE(buf ^ 1);
        __syncthreads();
    }
#undef AT_GLOAD
#undef AT_LSTORE
    l_run += __shfl_xor(l_run, 32);
    if (hi == 0) wsf[32 + r32] = l_run;
    LDS_WAIT();
    float rl[16];
#pragma unroll
    for (int g = 0; g < 4; ++g) { const f32x4 lv = *(const LAS f32x4*)(wsf + 32 + 8 * g + 4 * hi);
#pragma unroll
        for (int e = 0; e < 4; ++e) rl[4 * g + e] = __builtin_amdgcn_rcpf(lv[e]); }
    LDS_WAIT();
    bf16* Zw = Zp + (size_t)(q0 + wid * 32 + 4 * hi) * ldz + r32;
#pragma unroll
    for (int r = 0; r < 16; ++r) { bf16* zr = Zw + (size_t)((r & 3) + 8 * (r >> 2)) * ldz;
#pragma unroll
        for (int d0 = 0; d0 < 2; ++d0) { const float z = bf2f(zr[d0 * 32]); zr[d0 * 32] = f2bf(o[d0][r] * rl[r] * siluf(z)); } }
    __syncthreads();
}

__device__ __forceinline__ void sgu_unit(LAS unsigned char* lds, bf16* P  , const float* ln_g, const float* ln_b, const bf16* Wsb  , const float* bs  ) {
    const int tid = pg8::opaque_tid(), lane = tid & 63, r32 = lane & 31, hi = lane >> 5; const int wid = __builtin_amdgcn_readfirstlane(tid >> 6);
    f32x4 g0 = *(const f32x4*)(ln_g + lane * 8), g1 = *(const f32x4*)(ln_g + lane * 8 + 4), b0 = *(const f32x4*)(ln_b + lane * 8), b1 = *(const f32x4*)(ln_b + lane * 8 + 4);
    for (int rr = 0; rr < 16; ++rr) { const int row = wid * 16 + rr;
        const u32x4 w = *(const u32x4*)(P + (size_t)row * PW + C_VA + lane * 8);
        float x[8] = {pg8::bflo(w.x), pg8::bfhi(w.x), pg8::bflo(w.y), pg8::bfhi(w.y), pg8::bflo(w.z), pg8::bfhi(w.z), pg8::bflo(w.w), pg8::bfhi(w.w)};
        float s = 0.f;
#pragma unroll
        for (int e = 0; e < 8; ++e) s += x[e];
        const float mu = wave_sum(s) * (1.0f / 512.0f); float q = 0.f;
#pragma unroll
        for (int e = 0; e < 8; ++e) { x[e] -= mu; q += x[e] * x[e]; }
        const float rstd = 1.0f / sqrtf(wave_sum(q) * (1.0f / 512.0f) + EPS);
        u32x4 ow; ow.x = pk2(x[0] * rstd * g0[0] + b0[0], x[1] * rstd * g0[1] + b0[1]); ow.y = pk2(x[2] * rstd * g0[2] + b0[2], x[3] * rstd * g0[3] + b0[3]);
        ow.z = pk2(x[4] * rstd * g1[0] + b1[0], x[5] * rstd * g1[1] + b1[1]); ow.w = pk2(x[6] * rstd * g1[2] + b1[2], x[7] * rstd * g1[3] + b1[3]);
        *(LAS u32x4*)(lds + (lane >> 3) * 16384 + ((lane & 7) >> 2) * 8192 + (row >> 4) * 1024 + (row & 15) * 64 + (lane & 3) * 16) = ow; }
    __syncthreads();
    const int g = wid;
    const bf16* Wg = Wsb + (size_t)g * 128 * 128;
    const LAS unsigned char* vp = lds + g * 16384 + ((lane >> 4) & 1) * 32 + (lane & 3) * 8 + (4 * hi + ((lane & 15) >> 2)) * 64;
    for (int tb = 0; tb < 4; ++tb) {
        f32x16 acc[2]; acc[0] = (f32x16){}; acc[1] = (f32x16){};
        const bf16* wrow = Wg + (size_t)(32 * tb + r32) * 128 + 4 * hi;
        for (int ks = 0; ks <= 2 * tb + 1; ++ks) {
            const u32x2 alo = *(const u32x2*)(wrow + 16 * ks), ahi = *(const u32x2*)(wrow + 16 * ks + 8);
            const u32x4 aw = (u32x4){alo.x, alo.y, ahi.x, ahi.y};
#pragma unroll
            for (int d0 = 0; d0 < 2; ++d0) { const s16x4 lo = vtr(vp + d0 * 8192 + ks * 1024), hh = vtr(vp + d0 * 8192 + ks * 1024 + 512);
                const bf16x8 vf = (bf16x8){lo[0], lo[1], lo[2], lo[3], hh[0], hh[1], hh[2], hh[3]};
                acc[d0] = __builtin_amdgcn_mfma_f32_32x32x16_bf16(__builtin_bit_cast(bf16x8, aw), vf, acc[d0], 0, 0, 0); }
        }
#pragma unroll
        for (int r = 0; r < 16; ++r) { const int t = 32 * tb + (r & 3) + 8 * (r >> 2) + 4 * hi; const float bsv = bs[g * 128 + t];
            bf16* pr = P + (size_t)t * PW + g * 64 + r32;
#pragma unroll
            for (int d0 = 0; d0 < 2; ++d0) { const float u = bf2f(pr[C_UA + d0 * 32]), z = bf2f(pr[C_ZA + d0 * 32]); pr[C_ZA + d0 * 32] = f2bf(u * (acc[d0][r] + bsv) * siluf(z)); } }
    }
    __syncthreads();
}

__device__ __forceinline__ unsigned long long karg64(int off) {
    const volatile __attribute__((address_space(4))) unsigned* p = (const volatile __attribute__((address_space(4))) unsigned*)((const __attribute__((address_space(4))) char*)__builtin_amdgcn_kernarg_segment_ptr() + off);
    const unsigned lo = __builtin_amdgcn_readfirstlane(p[0]), hi = __builtin_amdgcn_readfirstlane(p[1]);
    return ((unsigned long long)hi << 32) | lo;
}
__device__ __forceinline__ int karg32(int off) {
    const volatile __attribute__((address_space(4))) unsigned* p = (const volatile __attribute__((address_space(4))) unsigned*)((const __attribute__((address_space(4))) char*)__builtin_amdgcn_kernarg_segment_ptr() + off);
    return (int)__builtin_amdgcn_readfirstlane(p[0]);
}
struct Args { const float* in[16]; float* out; unsigned char* ws; int ph_lo, ph_hi; };
__global__ void __launch_bounds__(NTHR, 2) mk_fwd(Args a) {
    extern __shared__ __attribute__((aligned(16))) unsigned char lds_raw[];
    cg::grid_group grid = cg::this_grid();
    LAS unsigned char* lds = (LAS unsigned char*)lds_raw;
    const int G = gridDim.x, bx = blockIdx.x; const int vcu = (G % 8 == 0) ? (bx % 8) * (G / 8) + bx / 8 : bx;
    const int NGW = G * NWAVES;
#define TID_SETUP const int tid = pg8::opaque_tid(), lane = tid & 63; const int wave = __builtin_amdgcn_readfirstlane(tid >> 6); const int gw = vcu * NWAVES + wave; (void)lane; (void)gw;
#define KARG64(off) karg64(off)
#define KIN(i) ((const float*)KARG64(8 * (i)))
#define KOUT ((float*)KARG64(128))
#define KWS ((unsigned char*)KARG64(136))
#define ws KWS
#define x_in KIN(0)
#define w_in KIN(1)
#define pre_g KIN(2)
#define post_g KIN(3)
#define sgu_ln_g KIN(4)
#define sgu_ln_b KIN(5)
#define sgu_w KIN(6)
#define sgu_b KIN(7)
#define q_norm_g KIN(8)
#define kv_norm_g KIN(9)
#define w_uq KIN(10)
#define w_ukv KIN(11)
#define rel_bias KIN(12)
#define w_branch KIN(13)
#define gate_b KIN(14)
#define w_out KIN(15)
#define xres KOUT
#define rcos ((float*)(KWS + WS_ROPE))
#define rsin (rcos + SEQ * 16)
#define rowstat ((float*)(KWS + WS_STAT))
#define KR ((bf16*)(KWS + WS_KR))
#define XB ((bf16*)(KWS + WS_XB))
#define PROJ ((bf16*)(KWS + WS_PROJ))
#define MQ ((bf16*)(KWS + WS_MQ))
#define MKV ((bf16*)(KWS + WS_MKV))
#define MACC ((float*)(KWS + WS_MACC))
#define HB ((float*)(KWS + WS_PROJ))
#define PH_LO karg32(144)
#define PH_HI karg32(148)
    int pc = 0;
#define PH_BEGIN if (pc >= PH_LO && pc < PH_HI) { TID_SETUP
#define PH_END if (pc + 1 < PH_HI) { asm volatile("s_waitcnt vmcnt(0)" ::: "memory");   grid.sync(); } } ++pc;

    PH_BEGIN
    {
        LAS float* scr = (LAS float*)(lds + wave * 16384);
        constexpr int I0 = 16 * 48, I1 = 16 * 80, I2 = 16 * 96, I3 = 16 * 13, IB = 8 * 32, IO = 16 * 32, IQ = 4 * 24, IK = 2 * 32;
        constexpr int IL = I0 + I1 + I2 + I3 + 3 * IB + IO + IQ + IK;
        for (int it = gw; it < DEPTH * IL; it += NGW) {
            const int l = it / IL; int r = it % IL;
            unsigned char* wl = ws + WS_W + (size_t)l * W_LAYER;
            const float* win = w_in + (size_t)l * DM * DIN; bf16* wint = (bf16*)(wl + WO_IN);
            if (r < I0) { tr_item(win + 0, DIN, 1536, nullptr, wint, DM, scr, r, lane); continue; } r -= I0;
            if (r < I1) { tr_item(win + 1952, DIN, 2560, nullptr, wint + (size_t)1536 * DM, DM, scr, r, lane); continue; } r -= I1;
            if (r < I2) { tr_item(win + 4512, DIN, 3072, nullptr, wint + (size_t)4096 * DM, DM, scr, r, lane); continue; } r -= I2;
            if (r < I3) { tr_item(win + 1536, DIN, 416, nullptr, wint + (size_t)7168 * DM, DM, scr, r, lane); continue; } r -= I3;
            if (r < 3 * IB) { const int i = r / IB; tr_item(w_branch + (size_t)(l * 3 + i) * 512 * DM, DM, DM, nullptr, (bf16*)(wl + WO_BR) + (size_t)i * DM * 512, 512, scr, r % IB, lane); continue; } r -= 3 * IB;
            if (r < IO) { tr_item(w_out + (size_t)l * DM * DM, DM, DM, nullptr, (bf16*)(wl + WO_OUT), DM, scr, r, lane); continue; } r -= IO;
            if (r < IQ) { tr_item(w_uq + (size_t)l * 256 * 768, 768, 768, q_norm_g + l * 256, (bf16*)(wl + WO_UQ), 256, scr, r, lane); continue; } r -= IQ;
            tr_item(w_ukv + (size_t)l * 128 * 1024, 1024, 1024, kv_norm_g + l * 128, (bf16*)(wl + WO_UKV), 128, scr, r, lane);
        }
        const int gt = vcu * NTHR + tid, NGT = G * NTHR;
        for (int i = gt; i < DEPTH * 8 * 128 * 128; i += NGT) { const int l = i >> 17, rem = i & 131071, t = (rem >> 7) & 127, s = rem & 127;
            ((bf16*)(ws + WS_W + (size_t)l * W_LAYER + WO_SGU))[rem] = f2bf(s <= t ? sgu_w[i] : 0.f); }
        for (int i = gt; i < DEPTH * 96 * DM / 8; i += NGT) { const int l = i / (96 * DM / 8), rem = i % (96 * DM / 8);
            ((u32x4*)(ws + WS_W + (size_t)l * W_LAYER + WO_IN + (size_t)DIN * DM * 2))[rem] = (u32x4){0u, 0u, 0u, 0u}; }
        for (int i = gt; i < SEQ * 16; i += NGT) { const int pos = i >> 4, k = i & 15; double inv = 1.0; for (int j = 0; j < k; ++j) inv *= 0.56234132519034908;
            const double ang = (double)pos * inv; const double n = __builtin_rint(ang * 0.15915494309189535); double r = ang - n * 6.283185307179586; r -= n * 2.4492935982947064e-16;
            const double r2 = r * r; double sp = -8.22063524662433e-18, cp = 4.110317623312165e-19;
            sp = sp * r2 + 2.8114572543455206e-15; cp = cp * r2 - 1.5619206968586225e-16;
            sp = sp * r2 - 7.647163731819816e-13;  cp = cp * r2 + 4.779477332387385e-14;
            sp = sp * r2 + 1.6059043836821613e-10; cp = cp * r2 - 1.1470745597729725e-11;
            sp = sp * r2 - 2.505210838544172e-08;  cp = cp * r2 + 2.08767569878681e-09;
            sp = sp * r2 + 2.7557319223985893e-06; cp = cp * r2 - 2.755731922398589e-07;
            sp = sp * r2 - 0.0001984126984126984;  cp = cp * r2 + 2.48015873015873e-05;
            sp = sp * r2 + 0.008333333333333333;   cp = cp * r2 - 0.001388888888888889;
            sp = sp * r2 - 0.16666666666666666;    cp = cp * r2 + 0.041666666666666664;
            sp = sp * r2 + 1.0;                    cp = cp * r2 - 0.5;
            cp = cp * r2 + 1.0;
            rcos[i] = (float)cp; rsin[i] = (float)(sp * r); }
    }
    PH_END

#pragma unroll 1
    for (int half = 0; half < 2; ++half) {
#pragma unroll 1
        for (int l = 0; l <= DEPTH; ++l) {
            PH_BEGIN
            {
                const float* xbase = (l <= 1) ? x_in : xres;
                for (int m = gw; m < MH; m += NGW) {
                    const size_t grow = (size_t)half * MH + m;
                    const f32x4* xr = (const f32x4*)(xbase + grow * DM) + lane;
                    f32x4 v[4];
#pragma unroll
                    for (int j = 0; j < 4; ++j) v[j] = xr[64 * j];
                    if (l > 0) {
                        const f32x4* hr = (const f32x4*)(HB + (size_t)m * DM) + lane; f32x4 h[4]; float s = 0.f;
#pragma unroll
                        for (int j = 0; j < 4; ++j) { h[j] = hr[64 * j]; s += (h[j].x * h[j].x + h[j].y * h[j].y) + (h[j].z * h[j].z + h[j].w * h[j].w); }
                        const float rinv = 1.0f / sqrtf(wave_sum(s) * (1.0f / DM) + EPS);
                        const f32x4* pg = (const f32x4*)(post_g + (size_t)(l - 1) * DM) + lane;
                        f32x4* xo = (f32x4*)(xres + grow * DM) + lane;
#pragma unroll
                        for (int j = 0; j < 4; ++j) { v[j] = v[j] + h[j] * rinv * pg[64 * j]; xo[64 * j] = v[j]; }
                    }
                    if (l < DEPTH) {
                        float s = 0.f;
#pragma unroll
                        for (int j = 0; j < 4; ++j) s += (v[j].x * v[j].x + v[j].y * v[j].y) + (v[j].z * v[j].z + v[j].w * v[j].w);
                        const float rinv = 1.0f / sqrtf(wave_sum(s) * (1.0f / DM) + EPS);
                        const f32x4* pg = (const f32x4*)(pre_g + (size_t)l * DM) + lane;
                        u32x2* o8 = (u32x2*)(XB + (size_t)m * DM) + lane;
#pragma unroll
                        for (int j = 0; j < 4; ++j) { const f32x4 t = v[j] * rinv * pg[64 * j]; o8[64 * j] = (u32x2){pk2(t.x, t.y), pk2(t.z, t.w)}; }
                    }
                }
            }
            PH_END
            if (l == DEPTH) continue;
#define wl (KWS + WS_W + (size_t)l * W_LAYER)

            PH_BEGIN
            {
                pg8::Gemm g{XB, (const bf16*)(wl + WO_IN), MH, PW, DM, DM, DM}; pg8::StaticOrder S; S.init(MH, PW, G, bx);
                pg8::EpiIn E{PROJ, PW, gate_b + (size_t)l * 3 * DM, rowstat};
                pg8::gemm_phase<pg8::EpiIn, pg8::StaticOrder, true, true>(lds, g, S, E);
            }
            PH_END

            PH_BEGIN
            {
                { pg8::Gemm g{PROJ + C_QD, (const bf16*)(wl + WO_UQ), MH, 768, 256, PW, 256}; pg8::StaticOrder S; S.init(MH, 768, G, bx);
                  pg8::EpiQ E{MQ, rowstat, rcos, rsin};
                  pg8::gemm_phase<pg8::EpiQ, pg8::StaticOrder, true, true>(lds, g, S, E); }
                { pg8::Gemm g{PROJ + C_KVD, (const bf16*)(wl + WO_UKV), MH, 1024, 128, PW, 128}; pg8::StaticOrder S; S.init(MH, 1024, G, bx);
                  pg8::EpiKV E{MKV, rowstat};
                  pg8::gemm_phase<pg8::EpiKV, pg8::StaticOrder, true, true>(lds, g, S, E); }
                const int gt = vcu * NTHR + tid, NGT = G * NTHR;
                for (int i = gt; i < MH * 16; i += NGT) { const int row = i >> 4, k = i & 15, pos = row & (SEQ - 1);
                    const float x1 = bf2f(PROJ[(size_t)row * PW + C_KR + k]), x2 = bf2f(PROJ[(size_t)row * PW + C_KR + 16 + k]);
                    const float c = rcos[pos * 16 + k], s = rsin[pos * 16 + k];
                    KR[(size_t)row * 32 + k] = f2bf(x1 * c - x2 * s); KR[(size_t)row * 32 + 16 + k] = f2bf(x1 * s + x2 * c); }
            }
            PH_END

            PH_BEGIN
            {
                for (int u = vcu; u < 512; u += G) { const int uu = u & 255, bh = uu >> 4, s = uu & 15, qb = (u < 256) ? s : 31 - s; const int bl = bh >> 3, h = bh & 7;
                    const size_t rb = (size_t)bl * SEQ;
                    attn_unit<96, false>(lds, MQ + rb * 768 + h * 96, 768, MKV + rb * 1024 + h * 128, 1024, KR + rb * 32, 32, MKV + rb * 1024 + h * 128 + 64, 1024,
                                         PROJ + rb * PW + C_ZB + h * 64, PW, qb * 256, nullptr, 0.10206207261596577f * LOG2E); }
                for (int u = vcu; u < 512; u += G) { const int bh = u >> 5, qb = u & 31; const int bl = bh >> 3, h = bh & 7;
                    bf16* pb = PROJ + (size_t)bl * SEQ * PW + h * 64;
                    attn_unit<64, true>(lds, pb + C_QC, PW, pb + C_KC, PW, pb + C_KC, PW, pb + C_VC, PW, pb + C_ZC, PW, qb * 256, rel_bias + (size_t)(l * 8 + h) * 257, 0.125f * LOG2E); }
                for (int u = bx; u < 128; u += G) { const int bl = u >> 6, blk = u & 63;
                    sgu_unit(lds, PROJ + ((size_t)bl * SEQ + blk * 128) * PW, sgu_ln_g + l * 512, sgu_ln_b + l * 512, (const bf16*)(wl + WO_SGU), sgu_b + (size_t)l * 8 * 128); }
            }
            PH_END

            PH_BEGIN
            {
                pg8::StaticOrder S; S.init(MH, DM, G, bx);
                { pg8::Gemm g{PROJ + C_ZA, (const bf16*)(wl + WO_BR), MH, DM, 512, PW, 512};
                  pg8::EpiMerge<0> E{PROJ + C_GATE, PW, MACC, XB}; pg8::gemm_phase<pg8::EpiMerge<0>, pg8::StaticOrder, true, true>(lds, g, S, E); }
                { pg8::Gemm g{PROJ + C_ZB, (const bf16*)(wl + WO_BR) + (size_t)DM * 512, MH, DM, 512, PW, 512};
                  pg8::EpiMerge<1> E{PROJ + C_GATE + DM, PW, MACC, XB}; pg8::gemm_phase<pg8::EpiMerge<1>, pg8::StaticOrder, true, true>(lds, g, S, E); }
                { pg8::Gemm g{PROJ + C_ZC, (const bf16*)(wl + WO_BR) + (size_t)2 * DM * 512, MH, DM, 512, PW, 512};
                  pg8::EpiMerge<2> E{PROJ + C_GATE + 2 * DM, PW, MACC, XB}; pg8::gemm_phase<pg8::EpiMerge<2>, pg8::StaticOrder, true, true>(lds, g, S, E); }
            }
            PH_END

            PH_BEGIN
            {
                pg8::Gemm g{XB, (const bf16*)(wl + WO_OUT), MH, DM, DM, DM, DM}; pg8::StaticOrder S; S.init(MH, DM, G, bx);
                pg8::EpiF32 E{HB, DM};
                pg8::gemm_phase<pg8::EpiF32, pg8::StaticOrder, true, true>(lds, g, S, E);
            }
            PH_END
        }
    }
#undef PH_BEGIN
#undef PH_END
}

#undef ws
#undef x_in
#undef w_in
#undef pre_g
#undef post_g
#undef sgu_ln_g
#undef sgu_ln_b
#undef sgu_w
#undef sgu_b
#undef q_norm_g
#undef kv_norm_g
#undef w_uq
#undef w_ukv
#undef rel_bias
#undef w_branch
#undef gate_b
#undef w_out
#undef xres
#undef rcos
#undef rsin
#undef rowstat
#undef KR
#undef XB
#undef PROJ
#undef MQ
#undef MKV
#undef MACC
#undef HB
#undef PH_LO
#undef PH_HI
#undef wl
extern "C" void kernel_launch(void* const* d_in, const int* in_sizes, int n_in, void* d_out, int out_size, void* d_ws, size_t ws_size, hipStream_t stream) {
    static int grid = 0;
    if (grid == 0) {
        if (n_in != 16 || out_size != MTOT * DM || ws_size < WS_END) { fprintf(stderr, "kernel_launch: unexpected shapes (n_in %d, out %d, ws %zu); nothing launched\n", n_in, out_size, ws_size); grid = -1; return; }
        int dev = 0, cus = 0, per_cu = 0;
        hipGetDevice(&dev); hipDeviceGetAttribute(&cus, hipDeviceAttributeMultiprocessorCount, dev);
        if (hipFuncSetAttribute((const void*)mk_fwd, hipFuncAttributeMaxDynamicSharedMemorySize, LDS_BYTES) != hipSuccess) { fprintf(stderr, "kernel_launch: hipFuncSetAttribute failed\n"); grid = -1; return; }
        if (hipOccupancyMaxActiveBlocksPerMultiprocessor(&per_cu, (const void*)mk_fwd, NTHR, LDS_BYTES) != hipSuccess || per_cu < 1) { fprintf(stderr, "kernel_launch: occupancy query says %d\n", per_cu); per_cu = 1; }
        (void)hipGetLastError();
        grid = cus;
    }
    if (grid < 0) return;
    Args a{};
    for (int i = 0; i < 16; ++i) a.in[i] = (const float*)d_in[i];
    a.out = (float*)d_out; a.ws = (unsigned char*)d_ws; a.ph_lo = 0; a.ph_hi = 1 << 30;
    void* args[] = {&a};
    hipError_t e = hipLaunchCooperativeKernel((const void*)mk_fwd, dim3(grid), dim3(NTHR), args, LDS_BYTES, stream);
    if (e != hipSuccess) fprintf(stderr, "cooperative launch failed: %s (grid %d)\n", hipGetErrorString(e), grid);
}
```

```cpp
#include <hip/hip_runtime.h>
#include <hip/hip_cooperative_groups.h>
#include <cstdio>
#include <cstdint>
namespace cg = cooperative_groups;
namespace pg8 {
#define PG8_LAS __attribute__((address_space(3)))
typedef unsigned short bf16_t;
typedef short bf16x8 __attribute__((ext_vector_type(8)));
typedef float f32x4 __attribute__((ext_vector_type(4)));
typedef unsigned u32x4 __attribute__((ext_vector_type(4)));
constexpr int BM = 256, BK = 64, HALF = 128, HTB = HALF * BK * 2  , STAGE_BYTES = 8 * HTB, NXCD = 8, WGM = 8;

__host__ __device__ __forceinline__ int lds_byte(int r, int c) { const int st = (r >> 4) * 2 + (c >> 5), rr = r & 15, cc = c & 31, ob = rr * 64 + cc * 2; return st * 1024 + (ob ^ (((ob >> 9) & 1) << 5)); }
__host__ __device__ __forceinline__ void stage_rc(int b, int& R, int& C) { const int st = b / 1024, sb = b % 1024, swz = sb ^ (((sb >> 9) & 1) << 5); R = (st >> 1) * 16 + swz / 64; C = (st & 1) * 32 + (swz % 64) / 2; }
__host__ __device__ __forceinline__ int perm32(int rho) { const int n = rho >> 4, i = rho & 15; return 8 * (i >> 2) + 4 * n + (i & 3); }

struct Unit { int pm, pn; };
struct Gemm { const bf16_t* A; const bf16_t* Bt; int M, N, K, lda, ldb; };

struct StaticOrder {
    int nM, nN, nwg, G, c;
    __host__ __device__ void init(int M, int N, int G_, int c_) { nM = M / BM; nN = N / BM; nwg = nM * nN; G = G_; c = c_; }
    __host__ __device__ bool next(int i, Unit& u) const {
        const long L = (long)i * G + c; if (L >= nwg) return false;
        int wgid = (int)L; { const int q = nwg / NXCD, r = nwg % NXCD, xcd = wgid % NXCD, off = wgid / NXCD; wgid = (xcd < r ? xcd * (q + 1) : r * (q + 1) + (xcd - r) * q) + off; }
        const int nig = WGM * nN, gid = wgid / nig, fm = gid * WGM, gsz = (nM - fm) < WGM ? (nM - fm) : WGM;
        u.pm = fm + ((wgid % nig) % gsz); u.pn = (wgid % nig) / gsz; return true;
    }
    __device__ __forceinline__ void a_ready(const Unit&) const {}
    __device__ __forceinline__ void done(const Unit&) const {}
};

__device__ __forceinline__ unsigned cvt_pk_bf16(float lo, float hi) { unsigned r; asm volatile("v_cvt_pk_bf16_f32 %0, %1, %2" : "=v"(r) : "v"(lo), "v"(hi)); return r; }
__device__ __forceinline__ int opaque_tid() { int t = threadIdx.x; asm volatile("" : "+v"(t)); return t; }
__device__ __forceinline__ float sigm(float v) { return __builtin_amdgcn_rcpf(1.0f + __builtin_amdgcn_exp2f(-1.4426950408889634f * v)); }
__device__ __forceinline__ float bflo(unsigned w) { return __uint_as_float(w << 16); }
__device__ __forceinline__ float bfhi(unsigned w) { return __uint_as_float(w & 0xffff0000u); }
__device__ __forceinline__ f32x4 shx32(f32x4 v) { f32x4 r; r[0] = __shfl_xor(v[0], 32); r[1] = __shfl_xor(v[1], 32); r[2] = __shfl_xor(v[2], 32); r[3] = __shfl_xor(v[3], 32); return r; }
constexpr float RMS_EPS = 1e-6f;

struct EpiIn {
    static constexpr bool PERM = true, AFTER_DRAIN = false;
    bf16_t* O; int ldc; const float* gate_b; float* rowstat;
    __device__ __forceinline__ void operator()(const f32x4 (&acc)[2][2][4][2], const Unit& u, int wr, int wc, int fr, int fq) const {
        const int row0 = u.pm * BM + wr * 64 + fr; const int col0 = u.pn * BM + wc * 32 + 8 * fq;
        const bool gate = (u.pn >= 16 && u.pn < 28);
        f32x4 bv[2][2];
#pragma unroll
        for (int bj = 0; bj < 2; ++bj)
#pragma unroll
            for (int n = 0; n < 2; ++n) bv[bj][n] = gate ? *(const f32x4*)(gate_b + (col0 - 4096) + bj * HALF + 4 * n) : (f32x4){0.f, 0.f, 0.f, 0.f};
#pragma unroll
        for (int ai = 0; ai < 2; ++ai)
#pragma unroll
            for (int m = 0; m < 4; ++m) { const int row = row0 + ai * HALF + m * 16; bf16_t* rowp = O + (size_t)row * ldc + col0; float ss = 0.f;
#pragma unroll
                for (int bj = 0; bj < 2; ++bj) { f32x4 v0 = acc[ai][bj][m][0] + bv[bj][0], v1 = acc[ai][bj][m][1] + bv[bj][1];
                    if (gate) { v0[0] = sigm(v0[0]); v0[1] = sigm(v0[1]); v0[2] = sigm(v0[2]); v0[3] = sigm(v0[3]); v1[0] = sigm(v1[0]); v1[1] = sigm(v1[1]); v1[2] = sigm(v1[2]); v1[3] = sigm(v1[3]); }
                    if (u.pn == 28 || (u.pn == 29 && bj == 0)) ss += (v0[0] * v0[0] + v0[1] * v0[1]) + (v0[2] * v0[2] + v0[3] * v0[3]) + (v1[0] * v1[0] + v1[1] * v1[1]) + (v1[2] * v1[2] + v1[3] * v1[3]);
                    u32x4 w; w.x = cvt_pk_bf16(v0[0], v0[1]); w.y = cvt_pk_bf16(v0[2], v0[3]); w.z = cvt_pk_bf16(v1[0], v1[1]); w.w = cvt_pk_bf16(v1[2], v1[3]);
                    *(u32x4*)(rowp + bj * HALF) = w; }
                if (u.pn >= 28) { ss += __shfl_xor(ss, 16); ss += __shfl_xor(ss, 32); if (fq == 0) rowstat[8 * row + (u.pn - 28) * 4 + wc] = ss; }
                asm volatile("" ::: "memory"); }
    }
};
struct EpiQ {
    static constexpr bool PERM = true, AFTER_DRAIN = false;
    bf16_t* O; const float* rowstat; const float* rcos; const float* rsin;
    __device__ __forceinline__ void operator()(const f32x4 (&acc)[2][2][4][2], const Unit& u, int wr, int wc, int fr, int fq) const {
        const int row0 = u.pm * BM + wr * 64 + fr; const int col0 = u.pn * BM + wc * 32 + 8 * fq;
        const float sgn = (fq >> 1) ? 1.f : -1.f; const int i0 = 8 * (fq & 1);
#pragma unroll
        for (int ai = 0; ai < 2; ++ai)
#pragma unroll
            for (int m = 0; m < 4; ++m) { const int row = row0 + ai * HALF + m * 16; const f32x4 rs4 = *(const f32x4*)(rowstat + 8 * row); const float sc = 1.0f / sqrtf(((rs4[0] + rs4[1]) + (rs4[2] + rs4[3])) * (1.0f / 256.0f) + RMS_EPS); const int pos = row & 8191;
#pragma unroll
                for (int bj = 0; bj < 2; ++bj) { f32x4 v0 = acc[ai][bj][m][0] * sc, v1 = acc[ai][bj][m][1] * sc;
                    const int grp = u.pn * 8 + bj * 4 + wc;
                    if (grp % 3 == 2) { const f32x4 p0 = shx32(v0), p1 = shx32(v1);
                        const f32x4 c0 = *(const f32x4*)(rcos + pos * 16 + i0), c1 = *(const f32x4*)(rcos + pos * 16 + i0 + 4), s0 = *(const f32x4*)(rsin + pos * 16 + i0), s1 = *(const f32x4*)(rsin + pos * 16 + i0 + 4);
                        v0 = v0 * c0 + (p0 * s0) * sgn; v1 = v1 * c1 + (p1 * s1) * sgn; }
                    u32x4 w; w.x = cvt_pk_bf16(v0[0], v0[1]); w.y = cvt_pk_bf16(v0[2], v0[3]); w.z = cvt_pk_bf16(v1[0], v1[1]); w.w = cvt_pk_bf16(v1[2], v1[3]);
                    *(u32x4*)(O + (size_t)row * 768 + col0 + bj * HALF) = w; }
                asm volatile("" ::: "memory"); }
    }
};
struct EpiKV {
    static constexpr bool PERM = true, AFTER_DRAIN = false;
    bf16_t* O; const float* rowstat;
    __device__ __forceinline__ void operator()(const f32x4 (&acc)[2][2][4][2], const Unit& u, int wr, int wc, int fr, int fq) const {
        const int row0 = u.pm * BM + wr * 64 + fr; const int col0 = u.pn * BM + wc * 32 + 8 * fq;
#pragma unroll
        for (int ai = 0; ai < 2; ++ai)
#pragma unroll
            for (int m = 0; m < 4; ++m) { const int row = row0 + ai * HALF + m * 16; const f32x4 rs4 = *(const f32x4*)(rowstat + 8 * row + 4); const float sc = 1.0f / sqrtf(((rs4[0] + rs4[1]) + (rs4[2] + rs4[3])) * (1.0f / 128.0f) + RMS_EPS);
#pragma unroll
                for (int bj = 0; bj < 2; ++bj) { const f32x4 v0 = acc[ai][bj][m][0] * sc, v1 = acc[ai][bj][m][1] * sc;
                    u32x4 w; w.x = cvt_pk_bf16(v0[0], v0[1]); w.y = cvt_pk_bf16(v0[2], v0[3]); w.z = cvt_pk_bf16(v1[0], v1[1]); w.w = cvt_pk_bf16(v1[2], v1[3]);
                    *(u32x4*)(O + (size_t)row * 1024 + col0 + bj * HALF) = w; }
                asm volatile("" ::: "memory"); }
    }
};
template <int I> struct EpiMerge {
    static constexpr bool PERM = true, AFTER_DRAIN = false;
    const bf16_t* G; int ldg; float* macc; bf16_t* O;
    __device__ __forceinline__ void operator()(const f32x4 (&acc)[2][2][4][2], const Unit& u, int wr, int wc, int fr, int fq) const {
        const int row0 = u.pm * BM + wr * 64 + fr; const int col0 = u.pn * BM + wc * 32 + 8 * fq;
#pragma unroll
        for (int ai = 0; ai < 2; ++ai)
#pragma unroll
            for (int m = 0; m < 4; ++m) { const int row = row0 + ai * HALF + m * 16;
#pragma unroll
                for (int bj = 0; bj < 2; ++bj) { const int col = col0 + bj * HALF; const u32x4 gw = *(const u32x4*)(G + (size_t)row * ldg + col);
                    f32x4 v0 = acc[ai][bj][m][0] * (f32x4){bflo(gw.x), bfhi(gw.x), bflo(gw.y), bfhi(gw.y)}, v1 = acc[ai][bj][m][1] * (f32x4){bflo(gw.z), bfhi(gw.z), bflo(gw.w), bfhi(gw.w)};
                    float* mp = macc + (size_t)row * 1024 + col;
                    if (I > 0) { v0 += *(const f32x4*)mp; v1 += *(const f32x4*)(mp + 4); }
                    if (I < 2) { *(f32x4*)mp = v0; *(f32x4*)(mp + 4) = v1; }
                    else { u32x4 w; w.x = cvt_pk_bf16(v0[0], v0[1]); w.y = cvt_pk_bf16(v0[2], v0[3]); w.z = cvt_pk_bf16(v1[0], v1[1]); w.w = cvt_pk_bf16(v1[2], v1[3]); *(u32x4*)(O + (size_t)row * 1024 + col) = w; } }
                asm volatile("" ::: "memory"); }
    }
};
struct EpiF32 {
    static constexpr bool PERM = false, AFTER_DRAIN = false;
    float* O; int ldc;
    __device__ __forceinline__ void operator()(const f32x4 (&acc)[2][2][4][2], const Unit& u, int wr, int wc, int fr, int fq) const {
        const int row0 = u.pm * BM + wr * 64 + fr; const int col0 = u.pn * BM + wc * 32 + 4 * fq;
#pragma unroll
        for (int ai = 0; ai < 2; ++ai)
#pragma unroll
            for (int m = 0; m < 4; ++m) { float* rowp = O + (size_t)(row0 + ai * HALF + m * 16) * ldc + col0;
#pragma unroll
                for (int bj = 0; bj < 2; ++bj)
#pragma unroll
                    for (int n = 0; n < 2; ++n) *(f32x4*)(rowp + bj * HALF + n * 16) = acc[ai][bj][m][n]; }
    }
};

template <class Epi, class Sched, bool ALIGN_EPI = false, bool SP2 = false>
__device__ __forceinline__ void gemm_phase(PG8_LAS unsigned char* lds, const Gemm g, const Sched& S, const Epi& E) {
    const int tid = opaque_tid(), wid = __builtin_amdgcn_readfirstlane(tid >> 6), lane = tid & 63, wr = wid >> 2, wc = wid & 3, fr = lane & 15, fq = lane >> 4;
    int Kop = g.K; asm volatile("" : "+s"(Kop)); const int K = Kop, nt = K / BK;
    unsigned voffA[2], voffB[2];
#pragma unroll
    for (int i = 0; i < 2; ++i) { int R, C; stage_rc(tid * 16 + i * 8192, R, C); const int Rb = Epi::PERM ? ((R & ~31) + perm32(R & 31)) : R;
        voffA[i] = (unsigned)(R * g.lda + C) * 2u; voffB[i] = (unsigned)(Rb * g.ldb + C) * 2u; }
    const size_t kstep = (size_t)(BK * 2);
    const size_t hstepA = (size_t)HALF * g.lda * 2, hstepB = (size_t)HALF * g.ldb * 2;
    const size_t tstepA = 2 * hstepA, tstepB = 2 * hstepB;
    const unsigned ldsw = (unsigned)wid * 1024u;
    const int aoff = lds_byte(wr * 64 + fr, fq * 8), boff = lds_byte(wc * 32 + fr, fq * 8);
#define PG8_SA(b, h) (((b) * 2 + (h)) * HTB)
#define PG8_SB(b, h) ((4 + (b) * 2 + (h)) * HTB)
#define PG8_STAGE(bufoff, gbase, voff) do { _Pragma("unroll") for (int _i = 0; _i < 2; ++_i) \
        __builtin_amdgcn_global_load_lds((const unsigned*)((const char*)(gbase) + (voff)[_i]), (PG8_LAS unsigned*)(lds + (bufoff) + ldsw + _i * 8192), 16, 0, 0); } while (0)
#define PG8_LDA(dst, b, h) do { _Pragma("unroll") for (int m = 0; m < 4; ++m) _Pragma("unroll") for (int k = 0; k < 2; ++k) dst[m][k] = *(const PG8_LAS bf16x8*)(lds + PG8_SA(b, h) + aoff + m * 2048 + k * 1024); } while (0)
#define PG8_LDB(dst, b, h) do { _Pragma("unroll") for (int n = 0; n < 2; ++n) _Pragma("unroll") for (int k = 0; k < 2; ++k) dst[n][k] = *(const PG8_LAS bf16x8*)(lds + PG8_SB(b, h) + boff + n * 2048 + k * 1024); } while (0)
#define PG8_MMA(ai, bj, At, Bt) do { __builtin_amdgcn_s_setprio(1); _Pragma("unroll") for (int m = 0; m < 4; ++m) _Pragma("unroll") for (int n = 0; n < 2; ++n) _Pragma("unroll") for (int k = 0; k < 2; ++k) \
        acc[ai][bj][m][n] = __builtin_amdgcn_mfma_f32_16x16x32_bf16(Bt[n][k], At[m][k], acc[ai][bj][m][n], 0, 0, 0); __builtin_amdgcn_s_setprio(0); } while (0)
#define PG8_WAIT_V(n) asm volatile("s_waitcnt vmcnt(" #n ")" ::: "memory")
#define PG8_WAIT_L(n) asm volatile("s_waitcnt lgkmcnt(" #n ")" ::: "memory")
#define PG8_BAR __builtin_amdgcn_s_barrier()
#define PG8_SCHED __builtin_amdgcn_sched_barrier(0)
    Unit cur, nxt; int ui = 0;
    if (!S.next(0, cur)) return;
    f32x4 acc[2][2][4][2];
#pragma unroll
    for (int a = 0; a < 2; ++a)
#pragma unroll
        for (int b = 0; b < 2; ++b)
#pragma unroll
            for (int m = 0; m < 4; ++m)
#pragma unroll
                for (int n = 0; n < 2; ++n) acc[a][b][m][n] = (f32x4){0.f, 0.f, 0.f, 0.f};
    bf16x8 At[4][2], B0[2][2], B1[2][2];
    const char* cA = (const char*)g.A + (size_t)cur.pm * tstepA; const char* cB = (const char*)g.Bt + (size_t)cur.pn * tstepB;
    S.a_ready(cur);
    if constexpr (SP2) {
        PG8_STAGE(PG8_SB(0, 0), cB, voffB); PG8_STAGE(PG8_SB(0, 1), cB + hstepB, voffB); PG8_STAGE(PG8_SA(0, 0), cA, voffA); PG8_STAGE(PG8_SA(0, 1), cA + hstepA, voffA);
        if (wr == 1) PG8_BAR;
        PG8_WAIT_V(2); PG8_BAR;
        PG8_STAGE(PG8_SB(1, 0), cB + kstep, voffB); PG8_STAGE(PG8_SA(1, 0), cA + kstep, voffA); PG8_STAGE(PG8_SB(1, 1), cB + hstepB + kstep, voffB);
        PG8_WAIT_V(6); PG8_BAR;
    } else {
        PG8_STAGE(PG8_SB(0, 0), cB, voffB); PG8_STAGE(PG8_SA(0, 0), cA, voffA); PG8_STAGE(PG8_SB(0, 1), cB + hstepB, voffB); PG8_STAGE(PG8_SA(0, 1), cA + hstepA, voffA);
        if (wr == 1) PG8_BAR;
        PG8_WAIT_V(4); PG8_BAR;
        PG8_STAGE(PG8_SB(1, 0), cB + kstep, voffB); PG8_STAGE(PG8_SA(1, 0), cA + kstep, voffA); PG8_STAGE(PG8_SB(1, 1), cB + hstepB + kstep, voffB);
        PG8_WAIT_V(6); PG8_BAR;
    }
    for (;;) {
        const bool has_next = S.next(ui + 1, nxt);
        const char* nA = has_next ? (const char*)g.A + (size_t)nxt.pm * tstepA : cA; const char* nB = has_next ? (const char*)g.Bt + (size_t)nxt.pn * tstepB : cB;
        for (int t = 0; t < nt; t += 2) {
            const bool last = (t == nt - 2);
            const char* a1 = cA + (size_t)(t + 1) * kstep;
            const char* a2 = last ? nA : cA + (size_t)(t + 2) * kstep; const char* b2 = last ? nB : cB + (size_t)(t + 2) * kstep;
            const char* a3 = a2 + kstep; const char* b3 = b2 + kstep;
            if (last && has_next) S.a_ready(nxt);
            if constexpr (SP2) {
            PG8_LDB(B0, 0, 0); PG8_LDB(B1, 0, 1); PG8_SCHED; PG8_LDA(At, 0, 0); PG8_STAGE(PG8_SA(1, 1), a1 + hstepA, voffA);
            PG8_WAIT_V(8); PG8_WAIT_L(0); PG8_BAR; PG8_MMA(0, 0, At, B0); PG8_MMA(0, 1, At, B1); PG8_BAR; PG8_SCHED;
            PG8_LDA(At, 0, 1); PG8_STAGE(PG8_SB(0, 0), b2, voffB); PG8_STAGE(PG8_SB(0, 1), b2 + hstepB, voffB); PG8_STAGE(PG8_SA(0, 0), a2, voffA);
            PG8_WAIT_V(8); PG8_WAIT_L(0); PG8_BAR; PG8_MMA(1, 0, At, B0); PG8_MMA(1, 1, At, B1); PG8_BAR; PG8_SCHED;
            PG8_LDB(B0, 1, 0); PG8_LDB(B1, 1, 1); PG8_SCHED; PG8_LDA(At, 1, 0); PG8_STAGE(PG8_SA(0, 1), a2 + hstepA, voffA);
            PG8_WAIT_V(8); PG8_WAIT_L(0); PG8_BAR; PG8_MMA(0, 0, At, B0); PG8_MMA(0, 1, At, B1); PG8_BAR; PG8_SCHED;
            PG8_LDA(At, 1, 1); PG8_STAGE(PG8_SB(1, 0), b3, voffB); PG8_STAGE(PG8_SB(1, 1), b3 + hstepB, voffB); PG8_STAGE(PG8_SA(1, 0), a3, voffA);
            PG8_WAIT_V(8); PG8_WAIT_L(0); PG8_BAR; PG8_MMA(1, 0, At, B0); PG8_MMA(1, 1, At, B1); PG8_BAR; PG8_SCHED;
            } else {
            PG8_LDB(B0, 0, 0); PG8_SCHED; PG8_LDA(At, 0, 0); PG8_STAGE(PG8_SA(1, 1), a1 + hstepA, voffA);
            PG8_WAIT_L(8); PG8_BAR; PG8_WAIT_L(0); PG8_MMA(0, 0, At, B0); PG8_BAR; PG8_SCHED;
            PG8_LDB(B1, 0, 1); PG8_STAGE(PG8_SB(0, 0), b2, voffB);
            PG8_BAR; PG8_WAIT_L(0); PG8_MMA(0, 1, At, B1); PG8_BAR;
            PG8_LDA(At, 0, 1); PG8_STAGE(PG8_SA(0, 0), a2, voffA);
            PG8_BAR; PG8_WAIT_L(0); PG8_MMA(1, 0, At, B0); PG8_BAR; PG8_SCHED;
            PG8_STAGE(PG8_SB(0, 1), b2 + hstepB, voffB);
            PG8_WAIT_V(6); PG8_BAR; PG8_MMA(1, 1, At, B1); PG8_BAR;
            PG8_LDB(B0, 1, 0); PG8_SCHED; PG8_LDA(At, 1, 0); PG8_STAGE(PG8_SA(0, 1), a2 + hstepA, voffA);
            PG8_WAIT_L(8); PG8_BAR; PG8_WAIT_L(0); PG8_MMA(0, 0, At, B0); PG8_BAR; PG8_SCHED;
            PG8_LDB(B1, 1, 1); PG8_STAGE(PG8_SB(1, 0), b3, voffB);
            PG8_BAR; PG8_WAIT_L(0); PG8_MMA(0, 1, At, B1); PG8_BAR;
            PG8_LDA(At, 1, 1); PG8_STAGE(PG8_SA(1, 0), a3, voffA);
            PG8_BAR; PG8_WAIT_L(0); PG8_MMA(1, 0, At, B0); PG8_BAR; PG8_SCHED;
            PG8_STAGE(PG8_SB(1, 1), b3 + hstepB, voffB);
            PG8_WAIT_V(6); PG8_BAR; PG8_MMA(1, 1, At, B1); PG8_BAR;
            }
        }
        if constexpr (ALIGN_EPI) { if (wr == 0) PG8_BAR; }
        if constexpr (!Epi::AFTER_DRAIN) { E(acc, cur, wr, wc, fr, fq); S.done(cur); }
        if (!has_next) break;
#pragma unroll
        for (int a = 0; a < 2; ++a)
#pragma unroll
            for (int b = 0; b < 2; ++b)
#pragma unroll
                for (int m = 0; m < 4; ++m)
#pragma unroll
                    for (int n = 0; n < 2; ++n) acc[a][b][m][n] = (f32x4){0.f, 0.f, 0.f, 0.f};
        cur = nxt; cA = nA; cB = nB; ++ui;
        if constexpr (ALIGN_EPI) { if (wr == 1) PG8_BAR; }
    }
    PG8_WAIT_V(0);
    if constexpr (!ALIGN_EPI) { if (wr == 0) PG8_BAR; }
    PG8_BAR;
    if constexpr (Epi::AFTER_DRAIN) { E.fused(acc, cur, wr, wc, fr, fq, lds, wid, lane); S.done(cur); }
#undef PG8_SA
#undef PG8_SB
#undef PG8_STAGE
#undef PG8_LDA
#undef PG8_LDB
#undef PG8_MMA
#undef PG8_WAIT_V
#undef PG8_WAIT_L
#undef PG8_BAR
#undef PG8_SCHED
}
}

typedef unsigned short bf16;
typedef short bf16x8 __attribute__((ext_vector_type(8)));
typedef short s16x4 __attribute__((ext_vector_type(4)));
typedef float f32x4 __attribute__((ext_vector_type(4)));
typedef float f32x16 __attribute__((ext_vector_type(16)));
typedef unsigned u32x4 __attribute__((ext_vector_type(4)));
typedef unsigned u32x2 __attribute__((ext_vector_type(2)));
#define LAS __attribute__((address_space(3)))
constexpr int NWAVES = 8, NTHR = 512;
constexpr int DM = 1024, SEQ = 8192, NB = 4, DEPTH = 4, MTOT = NB * SEQ, MH = MTOT / 2;
constexpr int DIN = 7584, PW = 7680;
constexpr int C_UA = 0, C_VA = 512, C_ZA = 1024, C_ZB = 1536, C_QC = 2048, C_KC = 2560, C_VC = 3072, C_ZC = 3584, C_GATE = 4096, C_QD = 7168, C_KVD = 7424, C_KR = 7552;
constexpr float EPS = 1e-6f, LOG2E = 1.4426950408889634f;
constexpr size_t MiB = 1u << 20;
constexpr size_t WS_ROPE = 1 * MiB, WS_STAT = 2 * MiB, WS_KR = 3 * MiB, WS_W = 4 * MiB, W_LAYER = 21 * MiB;
constexpr size_t WO_IN = 0, WO_BR = 15 * MiB, WO_OUT = 18 * MiB, WO_UQ = 20 * MiB, WO_UKV = 20 * MiB + 384 * 1024, WO_SGU = 20 * MiB + 640 * 1024;
constexpr size_t WS_XB = 88 * MiB, WS_PROJ = 120 * MiB, WS_MQ = 360 * MiB, WS_MKV = 384 * MiB, WS_MACC = 416 * MiB, WS_END = 480 * MiB;
constexpr int LDS_BYTES = 147456;
#ifndef REP_G1
#define REP_G1 1
#endif
#ifndef REP_MLA
#define REP_MLA 1
#endif
#ifndef REP_BAND
#define REP_BAND 1
#endif
#ifndef REP_SGU
#define REP_SGU 1
#endif
#ifndef REP_SYNC
#define REP_SYNC 1
#endif
#ifndef REP_REST
#define REP_REST 1
#endif

__device__ __forceinline__ float wave_sum(float v) {
#pragma unroll
    for (int o = 1; o < 64; o <<= 1) v += __shfl_xor(v, o);
    return v;
}
__device__ __forceinline__ unsigned pk2(float lo, float hi) { return pg8::cvt_pk_bf16(lo, hi); }
__device__ __forceinline__ float bf2f(bf16 b) { return __uint_as_float((unsigned)b << 16); }
__device__ __forceinline__ bf16 f2bf(float f) { return (bf16)(pk2(f, 0.f) & 0xffffu); }
__device__ __forceinline__ float siluf(float z) { return z * __builtin_amdgcn_rcpf(1.0f + __builtin_amdgcn_exp2f(-LOG2E * z)); }
#define LDS_WAIT() asm volatile("s_waitcnt lgkmcnt(0)" ::: "memory")

__device__ __forceinline__ void tr_item(const float* W, int ldw, int nseg, const float* kscale, bf16* WT, int K, LAS float* scr, int item, int lane) {
    const int nblk = nseg / 32, kb = item / nblk, nb = item % nblk, k0 = 64 * kb, n0 = 32 * nb;
#pragma unroll 8
    for (int i = 0; i < 32; ++i) { const int kk = 2 * i + (lane >> 5); float w = W[(size_t)(k0 + kk) * ldw + n0 + (lane & 31)]; if (kscale) w *= kscale[k0 + kk]; scr[kk * 33 + (lane & 31)] = w; }
    LDS_WAIT();
    const int c = lane & 7;
#pragma unroll
    for (int j = 0; j < 4; ++j) { const int n = (lane >> 3) + 8 * j; const LAS float* s = scr + (8 * c) * 33 + n;
        u32x4 o; o.x = pk2(s[0 * 33], s[1 * 33]); o.y = pk2(s[2 * 33], s[3 * 33]); o.z = pk2(s[4 * 33], s[5 * 33]); o.w = pk2(s[6 * 33], s[7 * 33]);
        *(u32x4*)(WT + (size_t)(n0 + n) * K + k0 + 8 * c) = o; }
    LDS_WAIT();
}

constexpr int AT_K = 0, AT_V = 24576, AT_WS = 40960, AT_TBL = 43008;
__device__ __forceinline__ s16x4 vtr(const LAS unsigned char* p) { typedef short v4i16_t __attribute__((ext_vector_type(4))); return __builtin_bit_cast(s16x4, __builtin_amdgcn_ds_read_tr16_b64_v4i16((LAS v4i16_t*)p)); }

template <int DQK, bool BIAS>
__device__ __forceinline__ void attn_unit(LAS unsigned char* lds, const bf16* Qp, int ldq, const bf16* Kp, int ldk, const bf16* KRp, int ldkr, const bf16* Vp, int ldv, const bf16* Zp, bf16* Yp, int ldz, int q0, const float* tblsrc, float C2) {
    constexpr int ND = DQK / 16;
    const int tid = pg8::opaque_tid(), lane = tid & 63, r32 = lane & 31, hi = lane >> 5; const int wid = __builtin_amdgcn_readfirstlane(tid >> 6);
    const int c0 = q0 >> 6, cw = c0 + (wid >> 1);
    const int t_hi = c0 + 3;
    const int t_lo = BIAS ? (c0 > 8 ? c0 - 8 : 0) : 0;
    const int w_lo = BIAS ? (cw > 8 ? cw - 8 : 0) : 0;
    bf16x8 qr[ND];
    { const bf16* Qw = Qp + (size_t)(q0 + wid * 32 + r32) * ldq + hi * 8;
#pragma unroll
      for (int d0 = 0; d0 < ND; ++d0) qr[d0] = *(const bf16x8*)(Qw + d0 * 16); }
    LAS float* wsf = (LAS float*)(lds + AT_WS) + wid * 64;
    LAS float* tbl = (LAS float*)(lds + AT_TBL);
    if (BIAS) { for (int i = tid; i < 257; i += NTHR) tbl[i] = tblsrc[i] * LOG2E; }
    u32x4 kreg0, kreg1, vreg; kreg1 = (u32x4){0u, 0u, 0u, 0u};
    const bf16* ksrc = Kp + (size_t)lane * ldk + wid * 8;
    const bf16* krsrc = KRp + (size_t)lane * ldkr + (wid & 3) * 8;
    const bf16* vsrc = Vp + (size_t)(16 * (wid & 3) + (lane >> 2)) * ldv + (wid >> 2) * 32 + (lane & 3) * 8;
#define AT_GLOAD(kt) do { kreg0 = *(const u32x4*)(ksrc + (size_t)(kt) * 64 * ldk); if (DQK == 96 && wid < 4) kreg1 = *(const u32x4*)(krsrc + (size_t)(kt) * 64 * ldkr); vreg = *(const u32x4*)(vsrc + (size_t)(kt) * 64 * ldv); } while (0)
#define AT_LSTORE(b) do { *(LAS u32x4*)(lds + AT_K + (b) * 12288 + tid * 16) = kreg0; if (DQK == 96 && wid < 4) *(LAS u32x4*)(lds + AT_K + (b) * 12288 + 8192 + tid * 16) = kreg1; *(LAS u32x4*)(lds + AT_V + (b) * 8192 + tid * 16) = vreg; } while (0)
    float m_run = -1e30f, l_run = 0.f; f32x16 o[2]; o[0] = (f32x16){}; o[1] = (f32x16){};
    AT_GLOAD(t_lo); AT_LSTORE(0);
    __syncthreads();
    int buf = 0;
    for (int kt = t_lo; kt <= t_hi; ++kt, buf ^= 1) {
        const bool more = kt < t_hi;
        if (more) AT_GLOAD(kt + 1);
        if (kt >= w_lo && kt <= cw) {
            f32x16 p0 = (f32x16){}, p1 = (f32x16){};
            const LAS unsigned char* kb = lds + AT_K + buf * 12288 + hi * 1024 + r32 * 16;
#pragma unroll
            for (int d0 = 0; d0 < ND; ++d0) {
                const bf16x8 a0 = *(const LAS bf16x8*)(kb + d0 * 2048), a1 = *(const LAS bf16x8*)(kb + d0 * 2048 + 512);
                p0 = __builtin_amdgcn_mfma_f32_32x32x16_bf16(a0, qr[d0], p0, 0, 0, 0); p1 = __builtin_amdgcn_mfma_f32_32x32x16_bf16(a1, qr[d0], p1, 0, 0, 0); }
            if (BIAS) {
                if (cw - kt >= 3) { const float bc = tbl[256];
#pragma unroll
                    for (int r = 0; r < 16; ++r) { p0[r] = p0[r] * C2 + bc; p1[r] = p1[r] * C2 + bc; } }
                else { const int dq = (q0 + wid * 32 + r32) - (kt * 64 + 4 * hi);
#pragma unroll
                    for (int r = 0; r < 16; ++r) { const int d = dq - ((r & 3) + 8 * (r >> 2)); const int i0 = (d < 128 ? d : 128) + 128, i1 = (d - 32 < 128 ? d - 32 : 128) + 128;
                        p0[r] = p0[r] * C2 + tbl[i0]; p1[r] = p1[r] * C2 + tbl[i1]; } }
            } else {
#pragma unroll
                for (int r = 0; r < 16; ++r) { p0[r] *= C2; p1[r] *= C2; }
            }
            float rm = fmaxf(p0[0], p1[0]);
#pragma unroll
            for (int r = 1; r < 16; ++r) rm = fmaxf(rm, fmaxf(p0[r], p1[r]));
            rm = fmaxf(rm, __shfl_xor(rm, 32));
            const float mnew = fmaxf(m_run, rm);
            if (__any(mnew > m_run)) {
                const float f = __builtin_amdgcn_exp2f(m_run - mnew); l_run *= f; m_run = mnew;
                if (hi == 0) wsf[r32] = f;
                LDS_WAIT();
#pragma unroll
                for (int g = 0; g < 4; ++g) { const f32x4 fv = *(const LAS f32x4*)(wsf + 8 * g + 4 * hi);
#pragma unroll
                    for (int e = 0; e < 4; ++e) { o[0][4 * g + e] *= fv[e]; o[1][4 * g + e] *= fv[e]; } }
                LDS_WAIT();
            }
            float ls = 0.f;
#pragma unroll
            for (int r = 0; r < 16; ++r) { p0[r] = __builtin_amdgcn_exp2f(p0[r] - m_run); p1[r] = __builtin_amdgcn_exp2f(p1[r] - m_run); ls += p0[r] + p1[r]; }
            l_run += ls;
            u32x4 pw[4];
#pragma unroll
            for (int e = 0; e < 4; ++e) { pw[0][e] = pk2(p0[2 * e], p0[2 * e + 1]); pw[1][e] = pk2(p0[8 + 2 * e], p0[8 + 2 * e + 1]); pw[2][e] = pk2(p1[2 * e], p1[2 * e + 1]); pw[3][e] = pk2(p1[8 + 2 * e], p1[8 + 2 * e + 1]); }
            const LAS unsigned char* vp = lds + AT_V + buf * 8192 + ((lane >> 4) & 1) * 32 + (lane & 3) * 8 + (4 * hi + ((lane & 15) >> 2)) * 64;
#pragma unroll
            for (int d0 = 0; d0 < 2; ++d0)
#pragma unroll
                for (int s = 0; s < 4; ++s) { const s16x4 lo = vtr(vp + d0 * 4096 + s * 1024), hh = vtr(vp + d0 * 4096 + s * 1024 + 512);
                    const bf16x8 vf = (bf16x8){lo[0], lo[1], lo[2], lo[3], hh[0], hh[1], hh[2], hh[3]};
                    o[d0] = __builtin_amdgcn_mfma_f32_32x32x16_bf16(__builtin_bit_cast(bf16x8, pw[s]), vf, o[d0], 0, 0, 0); }
        }
        if (more) AT_LSTORE(buf ^ 1);
        __syncthreads();
    }
#undef AT_GLOAD
#undef AT_LSTORE
    l_run += __shfl_xor(l_run, 32);
    if (hi == 0) wsf[32 + r32] = l_run;
    LDS_WAIT();
    float rl[16];
#pragma unroll
    for (int g = 0; g < 4; ++g) { const f32x4 lv = *(const LAS f32x4*)(wsf + 32 + 8 * g + 4 * hi);
#pragma unroll
        for (int e = 0; e < 4; ++e) rl[4 * g + e] = __builtin_amdgcn_rcpf(lv[e]); }
    LDS_WAIT();
    const size_t zoff = (size_t)(q0 + wid * 32 + 4 * hi) * ldz + r32;
#pragma unroll
    for (int r = 0; r < 16; ++r) { const size_t ro = zoff + (size_t)((r & 3) + 8 * (r >> 2)) * ldz;
#pragma unroll
        for (int d0 = 0; d0 < 2; ++d0) { const float z = bf2f(Zp[ro + d0 * 32]); Yp[ro + d0 * 32] = f2bf(o[d0][r] * rl[r] * siluf(z)); } }
    __syncthreads();
}

__device__ __forceinline__ void sgu_unit(LAS unsigned char* lds, bf16* P  , const float* ln_g, const float* ln_b, const bf16* Wsb  , const float* bs  , int ycol) {
    const int tid = pg8::opaque_tid(), lane = tid & 63, r32 = lane & 31, hi = lane >> 5; const int wid = __builtin_amdgcn_readfirstlane(tid >> 6);
    f32x4 g0 = *(const f32x4*)(ln_g + lane * 8), g1 = *(const f32x4*)(ln_g + lane * 8 + 4), b0 = *(const f32x4*)(ln_b + lane * 8), b1 = *(const f32x4*)(ln_b + lane * 8 + 4);
    for (int rr = 0; rr < 16; ++rr) { const int row = wid * 16 + rr;
        const u32x4 w = *(const u32x4*)(P + (size_t)row * PW + C_VA + lane * 8);
        float x[8] = {pg8::bflo(w.x), pg8::bfhi(w.x), pg8::bflo(w.y), pg8::bfhi(w.y), pg8::bflo(w.z), pg8::bfhi(w.z), pg8::bflo(w.w), pg8::bfhi(w.w)};
        float s = 0.f;
#pragma unroll
        for (int e = 0; e < 8; ++e) s += x[e];
        const float mu = wave_sum(s) * (1.0f / 512.0f); float q = 0.f;
#pragma unroll
        for (int e = 0; e < 8; ++e) { x[e] -= mu; q += x[e] * x[e]; }
        const float rstd = 1.0f / sqrtf(wave_sum(q) * (1.0f / 512.0f) + EPS);
        u32x4 ow; ow.x = pk2(x[0] * rstd * g0[0] + b0[0], x[1] * rstd * g0[1] + b0[1]); ow.y = pk2(x[2] * rstd * g0[2] + b0[2], x[3] * rstd * g0[3] + b0[3]);
        ow.z = pk2(x[4] * rstd * g1[0] + b1[0], x[5] * rstd * g1[1] + b1[1]); ow.w = pk2(x[6] * rstd * g1[2] + b1[2], x[7] * rstd * g1[3] + b1[3]);
        *(LAS u32x4*)(lds + (lane >> 3) * 16384 + ((lane & 7) >> 2) * 8192 + (row >> 4) * 1024 + (row & 15) * 64 + (lane & 3) * 16) = ow; }
    __syncthreads();
    const int g = wid;
    const bf16* Wg = Wsb + (size_t)g * 128 * 128;
    const LAS unsigned char* vp = lds + g * 16384 + ((lane >> 4) & 1) * 32 + (lane & 3) * 8 + (4 * hi + ((lane & 15) >> 2)) * 64;
    for (int tb = 0; tb < 4; ++tb) {
        f32x16 acc[2]; acc[0] = (f32x16){}; acc[1] = (f32x16){};
        const bf16* wrow = Wg + (size_t)(32 * tb + r32) * 128 + 4 * hi;
        for (int ks = 0; ks <= 2 * tb + 1; ++ks) {
            const u32x2 alo = *(const u32x2*)(wrow + 16 * ks), ahi = *(const u32x2*)(wrow + 16 * ks + 8);
            const u32x4 aw = (u32x4){alo.x, alo.y, ahi.x, ahi.y};
#pragma unroll
            for (int d0 = 0; d0 < 2; ++d0) { const s16x4 lo = vtr(vp + d0 * 8192 + ks * 1024), hh = vtr(vp + d0 * 8192 + ks * 1024 + 512);
                const bf16x8 vf = (bf16x8){lo[0], lo[1], lo[2], lo[3], hh[0], hh[1], hh[2], hh[3]};
                acc[d0] = __builtin_amdgcn_mfma_f32_32x32x16_bf16(__builtin_bit_cast(bf16x8, aw), vf, acc[d0], 0, 0, 0); }
        }
#pragma unroll
        for (int r = 0; r < 16; ++r) { const int t = 32 * tb + (r & 3) + 8 * (r >> 2) + 4 * hi; const float bsv = bs[g * 128 + t];
            bf16* pr = P + (size_t)t * PW + g * 64 + r32;
#pragma unroll
            for (int d0 = 0; d0 < 2; ++d0) { const float u = bf2f(pr[C_UA + d0 * 32]), z = bf2f(pr[C_ZA + d0 * 32]); pr[ycol + d0 * 32] = f2bf(u * (acc[d0][r] + bsv) * siluf(z)); } }
    }
    __syncthreads();
}

#define XB_TMO      128
#define XB_XCNT(j)  (256  + 64 * (j))
#define XB_XSUB(j)  (1280 + 64 * (j))
#define XB_XGEN(j)  (2304 + 64 * (j))
#define XB_TOP      3328
#define XB_TOPGEN   3392
#define XCD_BAR_WORDS 3456
#define XB_SPIN_CAP (1u << 18)

__device__ __forceinline__ unsigned xb_ld(unsigned* p)              { return __hip_atomic_load(p, __ATOMIC_RELAXED, __HIP_MEMORY_SCOPE_AGENT); }
__device__ __forceinline__ unsigned xb_add(unsigned* p, unsigned v) { return __hip_atomic_fetch_add(p, v, __ATOMIC_RELAXED, __HIP_MEMORY_SCOPE_AGENT); }
__device__ __forceinline__ unsigned xb_xcc_id() { return (unsigned)__builtin_amdgcn_s_getreg((3 << 11) | 20) & 0xFu; }
#define XB_SPIN(cond, bar) do { unsigned _sp = 0; while (cond) { __builtin_amdgcn_s_sleep(1); \
    if ((++_sp & 255u) == 0u) { if (xb_ld(&(bar)[XB_TMO])) break; if (_sp > XB_SPIN_CAP) { atomicAdd(&(bar)[XB_TMO], 1u); break; } } } } while (0)

struct XcdBarrier {
    unsigned* bar; unsigned x;
    volatile LAS unsigned* st;
};

__device__ __forceinline__ XcdBarrier xcd_barrier_post(unsigned* bar, volatile LAS unsigned* st) {
    XcdBarrier b; b.bar = bar; b.x = xb_xcc_id(); b.st = st;
    if (threadIdx.x == 0) (void)xb_add(&bar[XB_XCNT(b.x)], 1u);
    return b;
}
__device__ __forceinline__ void xcd_barrier_complete(unsigned* bar, unsigned x, unsigned& nloc, unsigned& nx) {
    const unsigned G = gridDim.x * gridDim.y * gridDim.z;
    unsigned sum, cnt, mine, sp = 0u;
    for (;;) {
        sum = 0u; cnt = 0u; mine = 0u;
#pragma unroll
        for (unsigned j = 0; j < 16; ++j) { const unsigned c = xb_ld(&bar[XB_XCNT(j)]); sum += c; cnt += (c > 0u) ? 1u : 0u; mine = (j == x) ? c : mine; }
        if (sum == G) break;
        __builtin_amdgcn_s_sleep(1);
        if ((++sp & 255u) == 0u) { if (xb_ld(&bar[XB_TMO])) break; if (sp > XB_SPIN_CAP) { atomicAdd(&bar[XB_TMO], 1u); break; } }
    }
    nloc = mine > 0u ? mine : 1u; nx = cnt > 0u ? cnt : 1u;
}

__device__ __forceinline__ void xcd_barrier(const XcdBarrier& b) {
    asm volatile("s_waitcnt vmcnt(0)" ::: "memory");
    __syncthreads();
    if (threadIdx.x == 0) {
        unsigned* bar = b.bar;
        __builtin_amdgcn_s_waitcnt(0);
        unsigned nloc = b.st[0], nx = b.st[1];
        if (nloc == 0u) { xcd_barrier_complete(bar, b.x, nloc, nx); b.st[0] = nloc; b.st[1] = nx; }
        const unsigned old = xb_add(&bar[XB_XSUB(b.x)], 1u);
        const unsigned gen = old / nloc;
        if (old + 1u == (gen + 1u) * nloc) {
            __builtin_amdgcn_fence(__ATOMIC_RELEASE, "agent");
            asm volatile("s_waitcnt vmcnt(0)" ::: "memory");
            const unsigned og = xb_add(&bar[XB_TOP], 1u);
            const unsigned tg = og / nx;
            if (og + 1u == (tg + 1u) * nx) xb_add(&bar[XB_TOPGEN], 1u);
            else XB_SPIN(xb_ld(&bar[XB_TOPGEN]) == tg, bar);
            __builtin_amdgcn_fence(__ATOMIC_ACQUIRE, "agent");
            xb_add(&bar[XB_XGEN(b.x)], 1u);
            asm volatile("s_waitcnt vmcnt(0)" ::: "memory");
        } else {
            XB_SPIN(xb_ld(&bar[XB_XGEN(b.x)]) == gen, bar);
            __builtin_amdgcn_fence(__ATOMIC_ACQUIRE, "agent");
            asm volatile("s_waitcnt vmcnt(0)" ::: "memory");
        }
    }
    __syncthreads();
}

__device__ __forceinline__ unsigned long long karg64(int off) {
    const volatile __attribute__((address_space(4))) unsigned* p = (const volatile __attribute__((address_space(4))) unsigned*)((const __attribute__((address_space(4))) char*)__builtin_amdgcn_kernarg_segment_ptr() + off);
    const unsigned lo = __builtin_amdgcn_readfirstlane(p[0]), hi = __builtin_amdgcn_readfirstlane(p[1]);
    return ((unsigned long long)hi << 32) | lo;
}
__device__ __forceinline__ int karg32(int off) {
    const volatile __attribute__((address_space(4))) unsigned* p = (const volatile __attribute__((address_space(4))) unsigned*)((const __attribute__((address_space(4))) char*)__builtin_amdgcn_kernarg_segment_ptr() + off);
    return (int)__builtin_amdgcn_readfirstlane(p[0]);
}
struct Args { const float* in[16]; float* out; unsigned char* ws; int ph_lo, ph_hi; };
__global__ void __launch_bounds__(NTHR, 2) mk_fwd(Args a) {
    extern __shared__ __attribute__((aligned(16))) unsigned char lds_raw[];
    cg::grid_group grid = cg::this_grid();
    LAS unsigned char* lds = (LAS unsigned char*)lds_raw;
    const int G = gridDim.x, bx = blockIdx.x; const int vcu = (G % 8 == 0) ? (bx % 8) * (G / 8) + bx / 8 : bx;
    const int NGW = G * NWAVES;
#define TID_SETUP const int tid = pg8::opaque_tid(), lane = tid & 63; const int wave = __builtin_amdgcn_readfirstlane(tid >> 6); const int gw = vcu * NWAVES + wave; (void)lane; (void)gw;
#define KARG64(off) karg64(off)
#define KIN(i) ((const float*)KARG64(8 * (i)))
#define KOUT ((float*)KARG64(128))
#define KWS ((unsigned char*)KARG64(136))
#define ws KWS
#define x_in KIN(0)
#define w_in KIN(1)
#define pre_g KIN(2)
#define post_g KIN(3)
#define sgu_ln_g KIN(4)
#define sgu_ln_b KIN(5)
#define sgu_w KIN(6)
#define sgu_b KIN(7)
#define q_norm_g KIN(8)
#define kv_norm_g KIN(9)
#define w_uq KIN(10)
#define w_ukv KIN(11)
#define rel_bias KIN(12)
#define w_branch KIN(13)
#define gate_b KIN(14)
#define w_out KIN(15)
#define xres KOUT
#define rcos ((float*)(KWS + WS_ROPE))
#define rsin (rcos + SEQ * 16)
#define rowstat ((float*)(KWS + WS_STAT))
#define KR ((bf16*)(KWS + WS_KR))
#define XB ((bf16*)(KWS + WS_XB))
#define PROJ ((bf16*)(KWS + WS_PROJ))
#define MQ ((bf16*)(KWS + WS_MQ))
#define MKV ((bf16*)(KWS + WS_MKV))
#define MACC ((float*)(KWS + WS_MACC))
#define HB ((float*)(KWS + WS_PROJ))
#define PH_LO karg32(144)
#define PH_HI karg32(148)
    if (threadIdx.x < 2) ((volatile LAS unsigned*)(lds + 131072))[threadIdx.x] = 0u;
    __syncthreads();
    (void)xcd_barrier_post((unsigned*)KWS, (volatile LAS unsigned*)(lds + 131072));
    int pc = 0;
#define PH_BEGIN if (pc >= PH_LO && pc < PH_HI) { TID_SETUP
#define PH_END if (pc + 1 < PH_HI) { asm volatile("s_waitcnt vmcnt(0)" ::: "memory");   for (int rs = 0; rs < REP_SYNC; ++rs) { if (pc == 0) grid.sync(); else { XcdBarrier xb_; xb_.bar = (unsigned*)KWS; xb_.x = xb_xcc_id(); xb_.st = (volatile LAS unsigned*)(lds + 131072); xcd_barrier(xb_); } } } } ++pc;

    PH_BEGIN
    {
        LAS float* scr = (LAS float*)(lds + wave * 16384);
        constexpr int I0 = 16 * 48, I1 = 16 * 80, I2 = 16 * 96, I3 = 16 * 13, IB = 8 * 32, IO = 16 * 32, IQ = 4 * 24, IK = 2 * 32;
        constexpr int IL = I0 + I1 + I2 + I3 + 3 * IB + IO + IQ + IK;
        for (int it = gw; it < DEPTH * IL; it += NGW) {
            const int l = it / IL; int r = it % IL;
            unsigned char* wl = ws + WS_W + (size_t)l * W_LAYER;
            const float* win = w_in + (size_t)l * DM * DIN; bf16* wint = (bf16*)(wl + WO_IN);
            if (r < I0) { tr_item(win + 0, DIN, 1536, nullptr, wint, DM, scr, r, lane); continue; } r -= I0;
            if (r < I1) { tr_item(win + 1952, DIN, 2560, nullptr, wint + (size_t)1536 * DM, DM, scr, r, lane); continue; } r -= I1;
            if (r < I2) { tr_item(win + 4512, DIN, 3072, nullptr, wint + (size_t)4096 * DM, DM, scr, r, lane); continue; } r -= I2;
            if (r < I3) { tr_item(win + 1536, DIN, 416, nullptr, wint + (size_t)7168 * DM, DM, scr, r, lane); continue; } r -= I3;
            if (r < 3 * IB) { const int i = r / IB; tr_item(w_branch + (size_t)(l * 3 + i) * 512 * DM, DM, DM, nullptr, (bf16*)(wl + WO_BR) + (size_t)i * DM * 512, 512, scr, r % IB, lane); continue; } r -= 3 * IB;
            if (r < IO) { tr_item(w_out + (size_t)l * DM * DM, DM, DM, nullptr, (bf16*)(wl + WO_OUT), DM, scr, r, lane); continue; } r -= IO;
            if (r < IQ) { tr_item(w_uq + (size_t)l * 256 * 768, 768, 768, q_norm_g + l * 256, (bf16*)(wl + WO_UQ), 256, scr, r, lane); continue; } r -= IQ;
            tr_item(w_ukv + (size_t)l * 128 * 1024, 1024, 1024, kv_norm_g + l * 128, (bf16*)(wl + WO_UKV), 128, scr, r, lane);
        }
        const int gt = vcu * NTHR + tid, NGT = G * NTHR;
        for (int i = gt; i < DEPTH * 8 * 128 * 128; i += NGT) { const int l = i >> 17, rem = i & 131071, t = (rem >> 7) & 127, s = rem & 127;
            ((bf16*)(ws + WS_W + (size_t)l * W_LAYER + WO_SGU))[rem] = f2bf(s <= t ? sgu_w[i] : 0.f); }
        for (int i = gt; i < DEPTH * 96 * DM / 8; i += NGT) { const int l = i / (96 * DM / 8), rem = i % (96 * DM / 8);
            ((u32x4*)(ws + WS_W + (size_t)l * W_LAYER + WO_IN + (size_t)DIN * DM * 2))[rem] = (u32x4){0u, 0u, 0u, 0u}; }
        for (int i = gt; i < SEQ * 16; i += NGT) { const int pos = i >> 4, k = i & 15; double inv = 1.0; for (int j = 0; j < k; ++j) inv *= 0.56234132519034908;
            const double ang = (double)pos * inv; const double n = __builtin_rint(ang * 0.15915494309189535); double r = ang - n * 6.283185307179586; r -= n * 2.4492935982947064e-16;
            const double r2 = r * r; double sp = -8.22063524662433e-18, cp = 4.110317623312165e-19;
            sp = sp * r2 + 2.8114572543455206e-15; cp = cp * r2 - 1.5619206968586225e-16;
            sp = sp * r2 - 7.647163731819816e-13;  cp = cp * r2 + 4.779477332387385e-14;
            sp = sp * r2 + 1.6059043836821613e-10; cp = cp * r2 - 1.1470745597729725e-11;
            sp = sp * r2 - 2.505210838544172e-08;  cp = cp * r2 + 2.08767569878681e-09;
            sp = sp * r2 + 2.7557319223985893e-06; cp = cp * r2 - 2.755731922398589e-07;
            sp = sp * r2 - 0.0001984126984126984;  cp = cp * r2 + 2.48015873015873e-05;
            sp = sp * r2 + 0.008333333333333333;   cp = cp * r2 - 0.001388888888888889;
            sp = sp * r2 - 0.16666666666666666;    cp = cp * r2 + 0.041666666666666664;
            sp = sp * r2 + 1.0;                    cp = cp * r2 - 0.5;
            cp = cp * r2 + 1.0;
            rcos[i] = (float)cp; rsin[i] = (float)(sp * r); }
    }
    PH_END

#pragma unroll 1
    for (int half = 0; half < 2; ++half) {
#pragma unroll 1
        for (int l = 0; l <= DEPTH; ++l) {
            PH_BEGIN
            {
                const float* xbase = (l <= 1) ? x_in : xres;
                for (int m = gw; m < MH; m += NGW) {
                    const size_t grow = (size_t)half * MH + m;
                    const f32x4* xr = (const f32x4*)(xbase + grow * DM) + lane;
                    f32x4 v[4];
#pragma unroll
                    for (int j = 0; j < 4; ++j) v[j] = xr[64 * j];
                    if (l > 0) {
                        const f32x4* hr = (const f32x4*)(HB + (size_t)m * DM) + lane; f32x4 h[4]; float s = 0.f;
#pragma unroll
                        for (int j = 0; j < 4; ++j) { h[j] = hr[64 * j]; s += (h[j].x * h[j].x + h[j].y * h[j].y) + (h[j].z * h[j].z + h[j].w * h[j].w); }
                        const float rinv = 1.0f / sqrtf(wave_sum(s) * (1.0f / DM) + EPS);
                        const f32x4* pg = (const f32x4*)(post_g + (size_t)(l - 1) * DM) + lane;
                        f32x4* xo = (f32x4*)(xres + grow * DM) + lane;
#pragma unroll
                        for (int j = 0; j < 4; ++j) { v[j] = v[j] + h[j] * rinv * pg[64 * j]; xo[64 * j] = v[j]; }
                    }
                    if (l < DEPTH) {
                        float s = 0.f;
#pragma unroll
                        for (int j = 0; j < 4; ++j) s += (v[j].x * v[j].x + v[j].y * v[j].y) + (v[j].z * v[j].z + v[j].w * v[j].w);
                        const float rinv = 1.0f / sqrtf(wave_sum(s) * (1.0f / DM) + EPS);
                        const f32x4* pg = (const f32x4*)(pre_g + (size_t)l * DM) + lane;
                        u32x2* o8 = (u32x2*)(XB + (size_t)m * DM) + lane;
#pragma unroll
                        for (int j = 0; j < 4; ++j) { const f32x4 t = v[j] * rinv * pg[64 * j]; o8[64 * j] = (u32x2){pk2(t.x, t.y), pk2(t.z, t.w)}; }
                    }
                }
            }
            PH_END
            if (l == DEPTH) continue;
#define wl (KWS + WS_W + (size_t)l * W_LAYER)

            PH_BEGIN
            {
                pg8::Gemm g{XB, (const bf16*)(wl + WO_IN), MH, PW, DM, DM, DM}; pg8::StaticOrder S; S.init(MH, PW, G, bx);
                pg8::EpiIn E{PROJ, PW, gate_b + (size_t)l * 3 * DM, rowstat};
                for (int rep = 0; rep < REP_G1; ++rep) pg8::gemm_phase<pg8::EpiIn, pg8::StaticOrder, true, true>(lds, g, S, E);
            }
            PH_END

            PH_BEGIN
            for (int rep = 0; rep < REP_REST; ++rep) {
                { pg8::Gemm g{PROJ + C_QD, (const bf16*)(wl + WO_UQ), MH, 768, 256, PW, 256}; pg8::StaticOrder S; S.init(MH, 768, G, bx);
                  pg8::EpiQ E{MQ, rowstat, rcos, rsin};
                  pg8::gemm_phase<pg8::EpiQ, pg8::StaticOrder, true, true>(lds, g, S, E); }
                { pg8::Gemm g{PROJ + C_KVD, (const bf16*)(wl + WO_UKV), MH, 1024, 128, PW, 128}; pg8::StaticOrder S; S.init(MH, 1024, G, bx);
                  pg8::EpiKV E{MKV, rowstat};
                  pg8::gemm_phase<pg8::EpiKV, pg8::StaticOrder, true, true>(lds, g, S, E); }
                const int gt = vcu * NTHR + tid, NGT = G * NTHR;
                for (int i = gt; i < MH * 16; i += NGT) { const int row = i >> 4, k = i & 15, pos = row & (SEQ - 1);
                    const float x1 = bf2f(PROJ[(size_t)row * PW + C_KR + k]), x2 = bf2f(PROJ[(size_t)row * PW + C_KR + 16 + k]);
                    const float c = rcos[pos * 16 + k], s = rsin[pos * 16 + k];
                    KR[(size_t)row * 32 + k] = f2bf(x1 * c - x2 * s); KR[(size_t)row * 32 + 16 + k] = f2bf(x1 * s + x2 * c); }
            }
            PH_END

            PH_BEGIN
            {
                for (int u = vcu; u < 512; u += G) { const int uu = u & 255, bh = uu >> 4, s = uu & 15, qb = (u < 256) ? s : 31 - s; const int bl = bh >> 3, h = bh & 7;
                    const size_t rb = (size_t)bl * SEQ;
                    for (int rep = 0; rep < REP_MLA; ++rep)
                    attn_unit<96, false>(lds, MQ + rb * 768 + h * 96, 768, MKV + rb * 1024 + h * 128, 1024, KR + rb * 32, 32, MKV + rb * 1024 + h * 128 + 64, 1024,
                                         PROJ + rb * PW + C_ZB + h * 64, PROJ + rb * PW + ((rep + 1 < REP_MLA) ? C_QD : C_ZB) + h * 64, PW, qb * 256, nullptr, 0.10206207261596577f * LOG2E); }
                for (int u = vcu; u < 512; u += G) { const int bh = u >> 5, qb = u & 31; const int bl = bh >> 3, h = bh & 7;
                    bf16* pb = PROJ + (size_t)bl * SEQ * PW + h * 64;
                    for (int rep = 0; rep < REP_BAND; ++rep)
                    attn_unit<64, true>(lds, pb + C_QC, PW, pb + C_KC, PW, pb + C_KC, PW, pb + C_VC, PW, pb + C_ZC, pb + ((rep + 1 < REP_BAND) ? C_QD : C_ZC), PW, qb * 256, rel_bias + (size_t)(l * 8 + h) * 257, 0.125f * LOG2E); }
                for (int u = bx; u < 128; u += G) { const int bl = u >> 6, blk = u & 63;
                    for (int rep = 0; rep < REP_SGU; ++rep)
                    sgu_unit(lds, PROJ + ((size_t)bl * SEQ + blk * 128) * PW, sgu_ln_g + l * 512, sgu_ln_b + l * 512, (const bf16*)(wl + WO_SGU), sgu_b + (size_t)l * 8 * 128, (rep + 1 < REP_SGU) ? C_QD : C_ZA); }
            }
            PH_END

            PH_BEGIN
            for (int rep = 0; rep < REP_REST; ++rep) {
                pg8::StaticOrder S; S.init(MH, DM, G, bx);
                { pg8::Gemm g{PROJ + C_ZA, (const bf16*)(wl + WO_BR), MH, DM, 512, PW, 512};
                  pg8::EpiMerge<0> E{PROJ + C_GATE, PW, MACC, XB}; pg8::gemm_phase<pg8::EpiMerge<0>, pg8::StaticOrder, true, true>(lds, g, S, E); }
                { pg8::Gemm g{PROJ + C_ZB, (const bf16*)(wl + WO_BR) + (size_t)DM * 512, MH, DM, 512, PW, 512};
                  pg8::EpiMerge<1> E{PROJ + C_GATE + DM, PW, MACC, XB}; pg8::gemm_phase<pg8::EpiMerge<1>, pg8::StaticOrder, true, true>(lds, g, S, E); }
                { pg8::Gemm g{PROJ + C_ZC, (const bf16*)(wl + WO_BR) + (size_t)2 * DM * 512, MH, DM, 512, PW, 512};
                  pg8::EpiMerge<2> E{PROJ + C_GATE + 2 * DM, PW, MACC, XB}; pg8::gemm_phase<pg8::EpiMerge<2>, pg8::StaticOrder, true, true>(lds, g, S, E); }
            }
            PH_END

            PH_BEGIN
            for (int rep = 0; rep < REP_REST; ++rep) {
                pg8::Gemm g{XB, (const bf16*)(wl + WO_OUT), MH, DM, DM, DM, DM}; pg8::StaticOrder S; S.init(MH, DM, G, bx);
                pg8::EpiF32 E{HB, DM};
                pg8::gemm_phase<pg8::EpiF32, pg8::StaticOrder, true, true>(lds, g, S, E);
            }
            PH_END
        }
    }
#undef PH_BEGIN
#undef PH_END
}

#undef ws
#undef x_in
#undef w_in
#undef pre_g
#undef post_g
#undef sgu_ln_g
#undef sgu_ln_b
#undef sgu_w
#undef sgu_b
#undef q_norm_g
#undef kv_norm_g
#undef w_uq
#undef w_ukv
#undef rel_bias
#undef w_branch
#undef gate_b
#undef w_out
#undef xres
#undef rcos
#undef rsin
#undef rowstat
#undef KR
#undef XB
#undef PROJ
#undef MQ
#undef MKV
#undef MACC
#undef HB
#undef PH_LO
#undef PH_HI
#undef wl
extern "C" void kernel_launch(void* const* d_in, const int* in_sizes, int n_in, void* d_out, int out_size, void* d_ws, size_t ws_size, hipStream_t stream) {
    static int grid = 0;
    if (grid == 0) {
        if (n_in != 16 || out_size != MTOT * DM || ws_size < WS_END) { fprintf(stderr, "kernel_launch: unexpected shapes (n_in %d, out %d, ws %zu); nothing launched\n", n_in, out_size, ws_size); grid = -1; return; }
        int dev = 0, cus = 0, per_cu = 0;
        hipGetDevice(&dev); hipDeviceGetAttribute(&cus, hipDeviceAttributeMultiprocessorCount, dev);
        if (hipFuncSetAttribute((const void*)mk_fwd, hipFuncAttributeMaxDynamicSharedMemorySize, LDS_BYTES) != hipSuccess) { fprintf(stderr, "kernel_launch: hipFuncSetAttribute failed\n"); grid = -1; return; }
        if (hipOccupancyMaxActiveBlocksPerMultiprocessor(&per_cu, (const void*)mk_fwd, NTHR, LDS_BYTES) != hipSuccess || per_cu < 1) { fprintf(stderr, "kernel_launch: occupancy query says %d\n", per_cu); per_cu = 1; }
        (void)hipGetLastError();
        grid = cus;
    }
    if (grid < 0) return;
    if (hipMemsetAsync(d_ws, 0, 65536, stream) != hipSuccess) { fprintf(stderr, "kernel_launch: memset failed\n"); return; }
    Args a{};
    for (int i = 0; i < 16; ++i) a.in[i] = (const float*)d_in[i];
    a.out = (float*)d_out; a.ws = (unsigned char*)d_ws; a.ph_lo = 0; a.ph_hi = 1 << 30;
    void* args[] = {&a};
    hipError_t e = hipLaunchCooperativeKernel((const void*)mk_fwd, dim3(grid), dim3(NTHR), args, LDS_BYTES, stream);
    if (e != hipSuccess) fprintf(stderr, "cooperative launch failed: %s (grid %d)\n", hipGetErrorString(e), grid);
}
```
